# Optimizing an MI355X kernel written in HIP

```python
import jax, jax.numpy as jnp
from jax import lax
import numpy as np

D_MODEL = 1024
BATCH = 2
SEQ = 8192
DEPTH = 1

CHUNK = 64
HEAD_SIZE = 64
D_RWKV = D_MODEL // 2
N_RWKV_HEADS = D_RWKV // HEAD_SIZE
D_SGU = D_MODEL - D_RWKV
N_SGU_HEADS = D_SGU // HEAD_SIZE
SGU_BLOCK = 128
D_DECAY_LORA = 64
D_AAA_LORA = 64
D_GATE_LORA = 128
N_SHIFT = 3 * D_RWKV + D_DECAY_LORA + D_AAA_LORA + D_GATE_LORA
D_IN = N_SHIFT + 2 * D_SGU
N_EXPERTS = 64
TOP_K = 8
N_GROUPS = 8
TOPK_GROUPS = 4
D_EXPERT = 256
ROUTED_SCALE = 2.5
MOE_BLOCK = 128
RMS_EPS = 1e-6
LN_EPS = 1e-5
LN_X_EPS = 64e-5

kernel_name = 'hymba_rwkv7_sgu_moe_adaln_block'


def rmsnorm(x, g):
    xf = x.astype(jnp.float32)
    y = xf * lax.rsqrt(jnp.mean(xf * xf, axis=-1, keepdims=True) + RMS_EPS)
    return (y * g.astype(jnp.float32)).astype(x.dtype)


def layernorm(x, g, b):
    xf = x.astype(jnp.float32)
    mu = jnp.mean(xf, axis=-1, keepdims=True)
    var = jnp.mean((xf - mu) ** 2, axis=-1, keepdims=True)
    y = (xf - mu) * lax.rsqrt(var + LN_EPS)
    return (y * g.astype(jnp.float32) + b.astype(jnp.float32)).astype(x.dtype)


def swiglu(h, w1, w3, w2):
    return (jax.nn.silu(h @ w1) * (h @ w3)) @ w2


def rwkv7_mix(ps, w0, w_decay_up, a0, w_a_up, w_g_up, k_k, k_a, r_k, lnx_g, lnx_b):
    B, S, _ = ps.shape
    f32 = jnp.float32
    c1, c2, c3 = D_RWKV, 2 * D_RWKV, 3 * D_RWKV
    c4, c5 = c3 + D_DECAY_LORA, c3 + D_DECAY_LORA + D_AAA_LORA
    r, k, v = ps[..., :c1], ps[..., c1:c2], ps[..., c2:c3]
    xw, xa, xg = ps[..., c3:c4], ps[..., c4:c5], ps[..., c5:]
    w = -jax.nn.softplus(-(w0 + jnp.tanh(xw) @ w_decay_up).astype(f32)) - 0.5
    decay = jnp.exp(-jnp.exp(w))
    a = jax.nn.sigmoid((a0 + xa @ w_a_up).astype(f32))
    g = jax.nn.sigmoid(xg) @ w_g_up
    heads = lambda t: t.reshape(B, S, N_RWKV_HEADS, HEAD_SIZE)
    kk = heads((k * k_k).astype(f32))
    kk = kk / jnp.maximum(jnp.sqrt(jnp.sum(kk * kk, axis=-1, keepdims=True)), 1e-12)
    a_h = heads(a)
    k_h = heads(k.astype(f32) * (1.0 + (a - 1.0) * k_a.astype(f32)))
    r_h = heads(r.astype(f32))
    v_h = heads(v.astype(f32))
    tm = lambda t: jnp.swapaxes(t, 0, 1)

    def step(state, inp):
        r_t, w_t, k_t, v_t, kk_t, a_t = inp
        sa = jnp.einsum('bhij,bhj->bhi', state, -kk_t)
        state = (state * w_t[:, :, None, :]
                 + sa[..., None] * (kk_t * a_t)[:, :, None, :]
                 + v_t[..., None] * k_t[:, :, None, :])
        y_t = jnp.einsum('bhij,bhj->bhi', state, r_t)
        return state, y_t

    s0 = jnp.zeros((B, N_RWKV_HEADS, HEAD_SIZE, HEAD_SIZE), f32)
    _, y = lax.scan(step, s0, (tm(r_h), tm(heads(decay)), tm(k_h), tm(v_h), tm(kk), tm(a_h)))
    y = tm(y)
    mu = jnp.mean(y, axis=-1, keepdims=True)
    var = jnp.mean((y - mu) ** 2, axis=-1, keepdims=True)
    y = ((y - mu) * lax.rsqrt(var + LN_X_EPS)).reshape(B, S, D_RWKV)
    y = y * lnx_g.astype(f32) + lnx_b.astype(f32)
    bonus = jnp.sum(r_h * k_h * r_k.astype(f32), axis=-1, keepdims=True) * v_h
    y = y + bonus.reshape(B, S, D_RWKV)
    return (y * g.astype(f32)).astype(ps.dtype)


def sgu_mix(pb, ln_g, ln_b, w_spatial, b_spatial):
    B, S, _ = pb.shape
    z = jax.nn.gelu(pb)
    u, v = z[..., :D_SGU], z[..., D_SGU:]
    v = layernorm(v, ln_g, ln_b)
    nb = S // SGU_BLOCK
    v = v.reshape(B, nb, SGU_BLOCK, N_SGU_HEADS, HEAD_SIZE)
    pos_chunk = jnp.arange(SGU_BLOCK) // CHUNK
    mask = pos_chunk[None, :] <= pos_chunk[:, None]
    ws = jnp.where(mask[None], w_spatial, 0.0).astype(v.dtype)
    sp = jnp.einsum('hts,bnshc->bnthc', ws, v) + b_spatial.T[:, :, None].astype(v.dtype)
    return u * sp.reshape(B, S, D_SGU)


def routed_moe(h, w_router, e_bias, w1_e, w3_e, w2_e):
    T, D = h.shape
    f32 = jnp.float32
    scores = jax.nn.sigmoid((h @ w_router).astype(f32))
    biased = scores + e_bias.astype(f32)
    per_group = N_EXPERTS // N_GROUPS
    grp_score = jnp.sum(lax.top_k(biased.reshape(T, N_GROUPS, per_group), 2)[0], axis=-1)
    _, gidx = lax.top_k(grp_score, TOPK_GROUPS)
    gmask = jnp.sum(jax.nn.one_hot(gidx, N_GROUPS, dtype=f32), axis=-2) > 0
    emask = jnp.repeat(gmask, per_group, axis=-1)
    _, eidx = lax.top_k(jnp.where(emask, biased, -jnp.inf), TOP_K)
    wts = jnp.take_along_axis(scores, eidx, axis=-1)
    wts = wts / jnp.sum(wts, axis=-1, keepdims=True) * ROUTED_SCALE

    A = T * TOP_K
    flat_e = eidx.reshape(A).astype(jnp.int32)
    flat_t = jnp.repeat(jnp.arange(T, dtype=jnp.int32), TOP_K)
    flat_w = wts.reshape(A)
    order = jnp.argsort(flat_e)
    se = flat_e[order]
    counts = jnp.bincount(flat_e, length=N_EXPERTS).astype(jnp.int32)
    padded = (counts + MOE_BLOCK - 1) // MOE_BLOCK * MOE_BLOCK
    start = jnp.cumsum(counts) - counts
    pend = jnp.cumsum(padded)
    pstart = pend - padded
    dest = pstart[se] + jnp.arange(A, dtype=jnp.int32) - start[se]
    n_blocks = (A + N_EXPERTS * (MOE_BLOCK - 1) + MOE_BLOCK - 1) // MOE_BLOCK
    P = n_blocks * MOE_BLOCK
    buf_t = jnp.zeros((P,), jnp.int32).at[dest].set(flat_t[order])
    buf_w = jnp.zeros((P,), f32).at[dest].set(flat_w[order])
    block_e = jnp.searchsorted(pend, jnp.arange(n_blocks, dtype=jnp.int32) * MOE_BLOCK, side='right')
    block_e = jnp.minimum(block_e, N_EXPERTS - 1)

    def block_fn(args):
        tok, e = args
        xb = h[tok]
        return swiglu(xb, w1_e[e], w3_e[e], w2_e[e])

    yb = lax.map(block_fn, (buf_t.reshape(n_blocks, MOE_BLOCK), block_e))
    yb = yb.reshape(P, D) * buf_w[:, None].astype(h.dtype)
    return jnp.zeros_like(h).at[buf_t].add(yb)


def setup_inputs(seed: int = 0) -> dict:
    key = jax.random.key(seed)
    ks = jax.random.split(key, 40)
    f32 = jnp.float32
    nrm = lambda k, shape, s: jax.random.normal(k, shape, f32) * s
    L, D = DEPTH, D_MODEL
    return {
        'x': nrm(ks[0], (BATCH, SEQ, D), 1.0),
        'c': nrm(ks[1], (BATCH, D), 1.0),
        'w_ada': nrm(ks[2], (L, D, 6 * D), 0.5 * D ** -0.5),
        'b_ada': nrm(ks[3], (L, 6 * D), 0.02),
        'norm1_g': 1.0 + nrm(ks[4], (L, D), 0.02),
        'w_in': nrm(ks[5], (L, D, D_IN), D ** -0.5),
        'mu_shift': jax.random.uniform(ks[6], (L, N_SHIFT), f32),
        'w0': jax.random.uniform(ks[7], (L, D_RWKV), f32, -3.0, 0.5),
        'w_decay_up': nrm(ks[8], (L, D_DECAY_LORA, D_RWKV), 0.1),
        'a0': nrm(ks[9], (L, D_RWKV), 0.1),
        'w_a_up': nrm(ks[10], (L, D_AAA_LORA, D_RWKV), D_AAA_LORA ** -0.5),
        'w_g_up': nrm(ks[11], (L, D_GATE_LORA, D_RWKV), D_GATE_LORA ** -0.5),
        'k_k': 0.85 + nrm(ks[12], (L, D_RWKV), 0.02),
        'k_a': 1.0 + nrm(ks[13], (L, D_RWKV), 0.02),
        'r_k': nrm(ks[14], (L, N_RWKV_HEADS, HEAD_SIZE), 0.1),
        'lnx_g': 1.0 + nrm(ks[15], (L, D_RWKV), 0.02),
        'lnx_b': nrm(ks[16], (L, D_RWKV), 0.02),
        'sgu_ln_g': 1.0 + nrm(ks[17], (L, D_SGU), 0.02),
        'sgu_ln_b': nrm(ks[18], (L, D_SGU), 0.02),
        'w_spatial': nrm(ks[19], (L, N_SGU_HEADS, SGU_BLOCK, SGU_BLOCK), SGU_BLOCK ** -0.5),
        'b_spatial': 1.0 + nrm(ks[20], (L, N_SGU_HEADS, SGU_BLOCK), 0.01),
        'w_out': nrm(ks[21], (L, D, D), D ** -0.5),
        'norm2_g': 1.0 + nrm(ks[22], (L, D), 0.02),
        'w_router': nrm(ks[23], (L, D, N_EXPERTS), D ** -0.5),
        'e_bias': nrm(ks[24], (L, N_EXPERTS), 0.01),
        'w1_e': nrm(ks[25], (L, N_EXPERTS, D, D_EXPERT), D ** -0.5),
        'w3_e': nrm(ks[26], (L, N_EXPERTS, D, D_EXPERT), D ** -0.5),
        'w2_e': nrm(ks[27], (L, N_EXPERTS, D_EXPERT, D), D_EXPERT ** -0.5),
        'w1_s': nrm(ks[28], (L, D, D_EXPERT), D ** -0.5),
        'w3_s': nrm(ks[29], (L, D, D_EXPERT), D ** -0.5),
        'w2_s': nrm(ks[30], (L, D_EXPERT, D), D_EXPERT ** -0.5),
        'norm_f_g': 1.0 + nrm(ks[31], (D,), 0.02),
    }


def reference(x, c, w_ada, b_ada, norm1_g, w_in, mu_shift, w0, w_decay_up, a0, w_a_up, w_g_up,
              k_k, k_a, r_k, lnx_g, lnx_b, sgu_ln_g, sgu_ln_b, w_spatial, b_spatial, w_out,
              norm2_g, w_router, e_bias, w1_e, w3_e, w2_e, w1_s, w3_s, w2_s, norm_f_g):
    B, S, D = x.shape
    for l in range(DEPTH):
        mod = (jax.nn.silu(c) @ w_ada[l] + b_ada[l])[:, None, :]
        sh1, sc1, g1, sh2, sc2, g2 = jnp.split(mod, 6, axis=-1)

        h = rmsnorm(x, norm1_g[l]) * (1.0 + sc1) + sh1
        proj = h @ w_in[l]
        ps = proj[..., :N_SHIFT]
        prev = jnp.pad(ps, ((0, 0), (1, 0), (0, 0)))[:, :-1]
        ps = ps + (prev - ps) * mu_shift[l]
        y_a = rwkv7_mix(ps, w0[l], w_decay_up[l], a0[l], w_a_up[l], w_g_up[l],
                        k_k[l], k_a[l], r_k[l], lnx_g[l], lnx_b[l])
        y_b = sgu_mix(proj[..., N_SHIFT:], sgu_ln_g[l], sgu_ln_b[l],
                      w_spatial[l], b_spatial[l])
        y = jnp.concatenate([y_a, y_b], axis=-1) @ w_out[l]
        x = x + g1 * y

        h2 = (rmsnorm(x, norm2_g[l]) * (1.0 + sc2) + sh2).reshape(B * S, D)
        m = swiglu(h2, w1_s[l], w3_s[l], w2_s[l]) + routed_moe(h2, w_router[l], e_bias[l],
                                                               w1_e[l], w3_e[l], w2_e[l])
        x = x + g2 * m.reshape(B, S, D)
    return rmsnorm(x, norm_f_g)
```

```cpp
#include <hip/hip_runtime.h>
#include <cstdio>
#include <cstdint>

namespace pg8 {
#define PG8_LAS __attribute__((address_space(3)))
typedef unsigned short bf16_t;
typedef short bf16x8 __attribute__((ext_vector_type(8)));
typedef float f32x4 __attribute__((ext_vector_type(4)));
typedef unsigned u32x4 __attribute__((ext_vector_type(4)));
constexpr int BM = 256, BK = 64, HALF = 128, HTB = HALF * BK * 2  , STAGE_BYTES = 8 * HTB, NXCD = 8, WGM = 8;

__host__ __device__ __forceinline__ int lds_byte(int r, int c) { const int st = (r >> 4) * 2 + (c >> 5), rr = r & 15, cc = c & 31, ob = rr * 64 + cc * 2; return st * 1024 + (ob ^ (((ob >> 9) & 1) << 5)); }
__host__ __device__ __forceinline__ void stage_rc(int b, int& R, int& C) { const int st = b / 1024, sb = b % 1024, swz = sb ^ (((sb >> 9) & 1) << 5); R = (st >> 1) * 16 + swz / 64; C = (st & 1) * 32 + (swz % 64) / 2; }
__host__ __device__ __forceinline__ int perm32(int rho) { const int n = rho >> 4, i = rho & 15; return 8 * (i >> 2) + 4 * n + (i & 3); }

struct Unit { int pm, pn, a0, a1, a2; };
struct Gemm { const bf16_t* A; const bf16_t* Bt; int M, N, K; };

struct StaticOrder {
    int nM, nN, nwg, G, c;
    __host__ __device__ void init(int M, int N, int G_, int c_) { nM = M / BM; nN = N / BM; nwg = nM * nN; G = G_; c = c_; }
    __host__ __device__ bool next(int i, Unit& u) const {
        const long L = (long)i * G + c; if (L >= nwg) return false;
        int wgid = (int)L; { const int q = nwg / NXCD, r = nwg % NXCD, xcd = wgid % NXCD, off = wgid / NXCD; wgid = (xcd < r ? xcd * (q + 1) : r * (q + 1) + (xcd - r) * q) + off; }
        const int nig = WGM * nN, gid = wgid / nig, fm = gid * WGM, gsz = (nM - fm) < WGM ? (nM - fm) : WGM;
        u.pm = fm + ((wgid % nig) % gsz); u.pn = (wgid % nig) / gsz; u.a0 = 0; u.a1 = 256; u.a2 = 0; return true;
    }
    __device__ __forceinline__ void a_ready(const Unit&) const {}
    __device__ __forceinline__ void done(const Unit&) const {}
};


__device__ __forceinline__ unsigned cvt_pk_bf16(float lo, float hi) { unsigned r; asm volatile("s_nop 1\n\tv_cvt_pk_bf16_f32 %0, %1, %2" : "=v"(r) : "v"(lo), "v"(hi)); return r; }
__device__ __forceinline__ float fsigmoid(float x) { return __builtin_amdgcn_rcpf(1.0f + __expf(-x)); }
__device__ __forceinline__ float fsilu(float x) { return x * fsigmoid(x); }

struct EpiBf16Plain {
    static constexpr bool PERM = true, AFTER_DRAIN = false;
    bf16_t* O; int ldc;
    __device__ __forceinline__ void operator()(const f32x4 (&acc)[2][2][4][2], const Unit& u, int wr, int wc, int fr, int fq) const {
        const int row0 = u.pm * BM + wr * 64 + fr; const int col0 = u.pn * BM + wc * 32 + 8 * fq;
#pragma unroll
        for (int ai = 0; ai < 2; ++ai)
#pragma unroll
            for (int m = 0; m < 4; ++m) { bf16_t* rowp = O + (size_t)(row0 + ai * HALF + m * 16) * ldc + col0;
#pragma unroll
                for (int bj = 0; bj < 2; ++bj) { const f32x4 v0 = acc[ai][bj][m][0], v1 = acc[ai][bj][m][1];
                    u32x4 w; w.x = cvt_pk_bf16(v0[0], v0[1]); w.y = cvt_pk_bf16(v0[2], v0[3]); w.z = cvt_pk_bf16(v1[0], v1[1]); w.w = cvt_pk_bf16(v1[2], v1[3]);
                    *(u32x4*)(rowp + bj * HALF) = w; } }
    }
};

struct EpiLora {
    static constexpr bool PERM = true, AFTER_DRAIN = false;
    _Float16* LW; bf16_t* Ab; bf16_t* Gb; const float* w0; const float* a0;
    template <int KIND> __device__ __forceinline__ void body(const f32x4 (&acc)[2][2][4][2], const Unit& u, int wr, int wc, int fr, int fq) const {
        const int row0 = u.pm * BM + wr * 64 + fr; const int colt = (u.pn & 1) * BM + wc * 32 + 8 * fq;
        const float* cbp = KIND == 0 ? w0 : a0;
#pragma unroll
        for (int bj = 0; bj < 2; ++bj) { float cb[8];
#pragma unroll
            for (int i = 0; i < 8; ++i) cb[i] = KIND == 2 ? 0.f : cbp[colt + bj * HALF + i];
#pragma unroll
            for (int ai = 0; ai < 2; ++ai)
#pragma unroll
                for (int m = 0; m < 4; ++m) { const size_t ro = (size_t)(row0 + ai * HALF + m * 16) * 512 + colt + bj * HALF; float v[8];
#pragma unroll
                    for (int i = 0; i < 4; ++i) { v[i] = acc[ai][bj][m][0][i] + cb[i]; v[4 + i] = acc[ai][bj][m][1][i] + cb[4 + i]; }
                    if (KIND == 0) {
                        typedef _Float16 h8 __attribute__((ext_vector_type(8))); h8 o;
#pragma unroll
                        for (int i = 0; i < 8; ++i) { const float z = -v[i]; const float sp = fmaxf(z, 0.f) + __logf(1.f + __expf(-fabsf(z)));
                            o[i] = (_Float16)(-__expf(-sp - 0.5f)); }
                        *(h8*)(LW + ro) = o;
                    } else {
                        if (KIND == 1) {
#pragma unroll
                            for (int i = 0; i < 8; ++i) v[i] = fsigmoid(v[i]); }
                        u32x4 w; w.x = cvt_pk_bf16(v[0], v[1]); w.y = cvt_pk_bf16(v[2], v[3]); w.z = cvt_pk_bf16(v[4], v[5]); w.w = cvt_pk_bf16(v[6], v[7]);
                        *(u32x4*)((KIND == 1 ? Ab : Gb) + ro) = w;
                    } } }
    }
    __device__ __forceinline__ void operator()(const f32x4 (&acc)[2][2][4][2], const Unit& u, int wr, int wc, int fr, int fq) const {
        const int kind = u.pn >> 1;
        if (kind == 0) body<0>(acc, u, wr, wc, fr, fq); else if (kind == 1) body<1>(acc, u, wr, wc, fr, fq); else body<2>(acc, u, wr, wc, fr, fq);
    }
};

struct EpiResGate {
    static constexpr bool PERM = false, AFTER_DRAIN = false;
    const float* base; float* out; const float* gate;
    int gstride;
    __device__ __forceinline__ void operator()(const f32x4 (&acc)[2][2][4][2], const Unit& u, int wr, int wc, int fr, int fq) const {
        const int col0 = u.pn * BM + wc * 32 + 4 * fq; const int b = (u.pm * BM) >> 13;
        f32x4 gv[2][2];
#pragma unroll
        for (int bj = 0; bj < 2; ++bj)
#pragma unroll
            for (int n = 0; n < 2; ++n) gv[bj][n] = *(const f32x4*)(gate + (size_t)b * gstride + col0 + bj * HALF + n * 16);
#pragma unroll
        for (int ai = 0; ai < 2; ++ai)
#pragma unroll
            for (int m = 0; m < 4; ++m) { const size_t off = (size_t)(u.pm * BM + ai * HALF + wr * 64 + m * 16 + fr) * 1024 + col0;
#pragma unroll
                for (int bj = 0; bj < 2; ++bj)
#pragma unroll
                    for (int n = 0; n < 2; ++n) { const f32x4 bs = *(const f32x4*)(base + off + bj * HALF + n * 16);
                        *(f32x4*)(out + off + bj * HALF + n * 16) = bs + gv[bj][n] * acc[ai][bj][m][n]; } }
    }
};

template <bool ROUTER> struct EpiSwiglu {
    static constexpr bool PERM = true, AFTER_DRAIN = false;
    bf16_t* Act; float* logits; int pn_per;
    __device__ __forceinline__ void operator()(const f32x4 (&acc)[2][2][4][2], const Unit& u, int wr, int wc, int fr, int fq) const {
        const int row0 = u.pm * BM + wr * 64 + fr; const int ht = u.pn % pn_per;
        if (ROUTER && ht == 2) {
            if (wc < 2) {
#pragma unroll
                for (int ai = 0; ai < 2; ++ai)
#pragma unroll
                    for (int m = 0; m < 4; ++m) { float* rp = logits + (size_t)(row0 + ai * HALF + m * 16) * 64 + wc * 32 + 8 * fq;
                        *(f32x4*)rp = acc[ai][0][m][0]; *(f32x4*)(rp + 4) = acc[ai][0][m][1]; }
            }
            return;
        }
        const int col0 = ht * 128 + wc * 32 + 8 * fq;
#pragma unroll
        for (int ai = 0; ai < 2; ++ai)
#pragma unroll
            for (int m = 0; m < 4; ++m) { float v[8];
#pragma unroll
                for (int i = 0; i < 4; ++i) { v[i] = fsilu(acc[ai][0][m][0][i]) * acc[ai][1][m][0][i]; v[4 + i] = fsilu(acc[ai][0][m][1][i]) * acc[ai][1][m][1][i]; }
                u32x4 w; w.x = cvt_pk_bf16(v[0], v[1]); w.y = cvt_pk_bf16(v[2], v[3]); w.z = cvt_pk_bf16(v[4], v[5]); w.w = cvt_pk_bf16(v[6], v[7]);
                *(u32x4*)(Act + (size_t)(row0 + ai * HALF + m * 16) * 256 + col0) = w; }
    }
};

struct EpiDownY {
    static constexpr bool PERM = true, AFTER_DRAIN = false;
    unsigned char* Y;
    __device__ __forceinline__ void operator()(const f32x4 (&acc)[2][2][4][2], const Unit& u, int wr, int wc, int fr, int fq) const {
        typedef unsigned u32x2 __attribute__((ext_vector_type(2)));
        const int col0 = u.a2 * BM + wc * 32 + 8 * fq;
#pragma unroll
        for (int ai = 0; ai < 2; ++ai)
#pragma unroll
            for (int m = 0; m < 4; ++m) { const int r = ai * HALF + wr * 64 + m * 16 + fr;
                if (r < u.a1) { unsigned char* rowp = Y + (size_t)(u.a0 + r) * 1024 + col0;
#pragma unroll
                    for (int bj = 0; bj < 2; ++bj) { const f32x4 v0 = acc[ai][bj][m][0] * 8.0f, v1 = acc[ai][bj][m][1] * 8.0f;
                        int w0 = __builtin_amdgcn_cvt_pk_fp8_f32(v0[0], v0[1], 0, false); w0 = __builtin_amdgcn_cvt_pk_fp8_f32(v0[2], v0[3], w0, true);
                        int w1 = __builtin_amdgcn_cvt_pk_fp8_f32(v1[0], v1[1], 0, false); w1 = __builtin_amdgcn_cvt_pk_fp8_f32(v1[2], v1[3], w1, true);
                        *(u32x2*)(rowp + bj * HALF) = (u32x2){(unsigned)w0, (unsigned)w1}; } } }
    }
};

template <class Epi, class Sched, bool ALIGN_EPI = false, bool SP2 = false>
__device__ __forceinline__ void gemm_phase(PG8_LAS unsigned char* lds, const Gemm g, const Sched& S, const Epi& E) {
    const int tid = threadIdx.x, wid = __builtin_amdgcn_readfirstlane(tid >> 6), lane = tid & 63, wr = wid >> 2, wc = wid & 3, fr = lane & 15, fq = lane >> 4;
    const int K = g.K, nt = K / BK;
    unsigned voffA[2], voffB[2];
#pragma unroll
    for (int i = 0; i < 2; ++i) { int R, C; stage_rc(tid * 16 + i * 8192, R, C); const int Rb = Epi::PERM ? ((R & ~31) + perm32(R & 31)) : R;
        voffA[i] = (unsigned)(R * K + C) * 2u; voffB[i] = (unsigned)(Rb * K + C) * 2u; }
    const size_t kstep = (size_t)(BK * 2);
    const size_t hstep = (size_t)HALF * K * 2;
    const size_t tstep = 2 * hstep;
    const unsigned ldsw = (unsigned)wid * 1024u;
    const int aoff = lds_byte(wr * 64 + fr, fq * 8), boff = lds_byte(wc * 32 + fr, fq * 8);
#define PG8_SA(b, h) (((b) * 2 + (h)) * HTB)
#define PG8_SB(b, h) ((4 + (b) * 2 + (h)) * HTB)
#define PG8_STAGE(bufoff, gbase, voff) do { _Pragma("unroll") for (int _i = 0; _i < 2; ++_i) \
        __builtin_amdgcn_global_load_lds((const unsigned*)((const char*)(gbase) + (voff)[_i]), (PG8_LAS unsigned*)(lds + (bufoff) + ldsw + _i * 8192), 16, 0, 0); } while (0)
#define PG8_LDA(dst, b, h) do { _Pragma("unroll") for (int m = 0; m < 4; ++m) _Pragma("unroll") for (int k = 0; k < 2; ++k) dst[m][k] = *(const PG8_LAS bf16x8*)(lds + PG8_SA(b, h) + aoff + m * 2048 + k * 1024); } while (0)
#define PG8_LDB(dst, b, h) do { _Pragma("unroll") for (int n = 0; n < 2; ++n) _Pragma("unroll") for (int k = 0; k < 2; ++k) dst[n][k] = *(const PG8_LAS bf16x8*)(lds + PG8_SB(b, h) + boff + n * 2048 + k * 1024); } while (0)
#define PG8_MMA(ai, bj, At, Bt) do { __builtin_amdgcn_s_setprio(1); _Pragma("unroll") for (int m = 0; m < 4; ++m) _Pragma("unroll") for (int n = 0; n < 2; ++n) _Pragma("unroll") for (int k = 0; k < 2; ++k) \
        acc[ai][bj][m][n] = __builtin_amdgcn_mfma_f32_16x16x32_bf16(Bt[n][k], At[m][k], acc[ai][bj][m][n], 0, 0, 0); __builtin_amdgcn_s_setprio(0); } while (0)
#define PG8_WAIT_V(n) asm volatile("s_waitcnt vmcnt(" #n ")" ::: "memory")
#define PG8_WAIT_L(n) asm volatile("s_waitcnt lgkmcnt(" #n ")" ::: "memory")
#define PG8_BAR __builtin_amdgcn_s_barrier()
#define PG8_SCHED __builtin_amdgcn_sched_barrier(0)
    Unit cur, nxt; int ui = 0;
    if (!S.next(0, cur)) return;
    f32x4 acc[2][2][4][2];
#pragma unroll
    for (int a = 0; a < 2; ++a)
#pragma unroll
        for (int b = 0; b < 2; ++b)
#pragma unroll
            for (int m = 0; m < 4; ++m)
#pragma unroll
                for (int n = 0; n < 2; ++n) acc[a][b][m][n] = (f32x4){0.f, 0.f, 0.f, 0.f};
    bf16x8 At[4][2], B0[2][2], B1[2][2];
    const char* cA = (const char*)g.A + (size_t)cur.pm * tstep; const char* cB = (const char*)g.Bt + (size_t)cur.pn * tstep;
    S.a_ready(cur);
    if constexpr (SP2) {
        PG8_STAGE(PG8_SB(0, 0), cB, voffB); PG8_STAGE(PG8_SB(0, 1), cB + hstep, voffB); PG8_STAGE(PG8_SA(0, 0), cA, voffA); PG8_STAGE(PG8_SA(0, 1), cA + hstep, voffA);
        if (wr == 1) PG8_BAR;
        PG8_WAIT_V(2); PG8_BAR;
        PG8_STAGE(PG8_SB(1, 0), cB + kstep, voffB); PG8_STAGE(PG8_SA(1, 0), cA + kstep, voffA); PG8_STAGE(PG8_SB(1, 1), cB + hstep + kstep, voffB);
        PG8_WAIT_V(6); PG8_BAR;
    } else {
        PG8_STAGE(PG8_SB(0, 0), cB, voffB); PG8_STAGE(PG8_SA(0, 0), cA, voffA); PG8_STAGE(PG8_SB(0, 1), cB + hstep, voffB); PG8_STAGE(PG8_SA(0, 1), cA + hstep, voffA);
        if (wr == 1) PG8_BAR;
        PG8_WAIT_V(4); PG8_BAR;
        PG8_STAGE(PG8_SB(1, 0), cB + kstep, voffB); PG8_STAGE(PG8_SA(1, 0), cA + kstep, voffA); PG8_STAGE(PG8_SB(1, 1), cB + hstep + kstep, voffB);
        PG8_WAIT_V(6); PG8_BAR;
    }
    for (;;) {
        const bool has_next = S.next(ui + 1, nxt);
        const char* nA = has_next ? (const char*)g.A + (size_t)nxt.pm * tstep : cA; const char* nB = has_next ? (const char*)g.Bt + (size_t)nxt.pn * tstep : cB;
#pragma unroll 1
        for (int t = 0; t < nt; t += 2) {
            const bool last = (t == nt - 2);
            const char* a1 = cA + (size_t)(t + 1) * kstep;
            const char* a2 = last ? nA : cA + (size_t)(t + 2) * kstep; const char* b2 = last ? nB : cB + (size_t)(t + 2) * kstep;
            const char* a3 = a2 + kstep; const char* b3 = b2 + kstep;
            if (last && has_next) S.a_ready(nxt);
            if constexpr (SP2) {
            PG8_LDB(B0, 0, 0); PG8_LDB(B1, 0, 1); PG8_SCHED; PG8_LDA(At, 0, 0); PG8_STAGE(PG8_SA(1, 1), a1 + hstep, voffA);
            PG8_WAIT_V(8); PG8_WAIT_L(0); PG8_BAR; PG8_MMA(0, 0, At, B0); PG8_MMA(0, 1, At, B1); PG8_BAR; PG8_SCHED;
            PG8_LDA(At, 0, 1); PG8_STAGE(PG8_SB(0, 0), b2, voffB); PG8_STAGE(PG8_SB(0, 1), b2 + hstep, voffB); PG8_STAGE(PG8_SA(0, 0), a2, voffA);
            PG8_WAIT_V(8); PG8_WAIT_L(0); PG8_BAR; PG8_MMA(1, 0, At, B0); PG8_MMA(1, 1, At, B1); PG8_BAR; PG8_SCHED;
            PG8_LDB(B0, 1, 0); PG8_LDB(B1, 1, 1); PG8_SCHED; PG8_LDA(At, 1, 0); PG8_STAGE(PG8_SA(0, 1), a2 + hstep, voffA);
            PG8_WAIT_V(8); PG8_WAIT_L(0); PG8_BAR; PG8_MMA(0, 0, At, B0); PG8_MMA(0, 1, At, B1); PG8_BAR; PG8_SCHED;
            PG8_LDA(At, 1, 1); PG8_STAGE(PG8_SB(1, 0), b3, voffB); PG8_STAGE(PG8_SB(1, 1), b3 + hstep, voffB); PG8_STAGE(PG8_SA(1, 0), a3, voffA);
            PG8_WAIT_V(8); PG8_WAIT_L(0); PG8_BAR; PG8_MMA(1, 0, At, B0); PG8_MMA(1, 1, At, B1); PG8_BAR; PG8_SCHED;
            } else {
            PG8_LDB(B0, 0, 0); PG8_SCHED; PG8_LDA(At, 0, 0); PG8_STAGE(PG8_SA(1, 1), a1 + hstep, voffA);
            PG8_WAIT_L(8); PG8_BAR; PG8_WAIT_L(0); PG8_MMA(0, 0, At, B0); PG8_BAR; PG8_SCHED;
            PG8_LDB(B1, 0, 1); PG8_STAGE(PG8_SB(0, 0), b2, voffB);
            PG8_BAR; PG8_WAIT_L(0); PG8_MMA(0, 1, At, B1); PG8_BAR;
            PG8_LDA(At, 0, 1); PG8_STAGE(PG8_SA(0, 0), a2, voffA);
            PG8_BAR; PG8_WAIT_L(0); PG8_MMA(1, 0, At, B0); PG8_BAR; PG8_SCHED;
            PG8_STAGE(PG8_SB(0, 1), b2 + hstep, voffB);
            PG8_WAIT_V(6); PG8_BAR; PG8_MMA(1, 1, At, B1); PG8_BAR;
            PG8_LDB(B0, 1, 0); PG8_SCHED; PG8_LDA(At, 1, 0); PG8_STAGE(PG8_SA(0, 1), a2 + hstep, voffA);
            PG8_WAIT_L(8); PG8_BAR; PG8_WAIT_L(0); PG8_MMA(0, 0, At, B0); PG8_BAR; PG8_SCHED;
            PG8_LDB(B1, 1, 1); PG8_STAGE(PG8_SB(1, 0), b3, voffB);
            PG8_BAR; PG8_WAIT_L(0); PG8_MMA(0, 1, At, B1); PG8_BAR;
            PG8_LDA(At, 1, 1); PG8_STAGE(PG8_SA(1, 0), a3, voffA);
            PG8_BAR; PG8_WAIT_L(0); PG8_MMA(1, 0, At, B0); PG8_BAR; PG8_SCHED;
            PG8_STAGE(PG8_SB(1, 1), b3 + hstep, voffB);
            PG8_WAIT_V(6); PG8_BAR; PG8_MMA(1, 1, At, B1); PG8_BAR;
            }
        }
        if constexpr (ALIGN_EPI) { if (wr == 0) PG8_BAR; }
        if constexpr (!Epi::AFTER_DRAIN) { E(acc, cur, wr, wc, fr, fq); S.done(cur); }
        if (!has_next) break;
#pragma unroll
        for (int a = 0; a < 2; ++a)
#pragma unroll
            for (int b = 0; b < 2; ++b)
#pragma unroll
                for (int m = 0; m < 4; ++m)
#pragma unroll
                    for (int n = 0; n < 2; ++n) acc[a][b][m][n] = (f32x4){0.f, 0.f, 0.f, 0.f};
        cur = nxt; cA = nA; cB = nB; ++ui;
        if constexpr (ALIGN_EPI) { if (wr == 1) PG8_BAR; }
    }
    PG8_WAIT_V(0);
    if constexpr (!ALIGN_EPI) { if (wr == 0) PG8_BAR; }
    PG8_BAR;
    if constexpr (Epi::AFTER_DRAIN) { E.fused(acc, cur, wr, wc, fr, fq, lds, wid, lane); S.done(cur); }
#undef PG8_SA
#undef PG8_SB
#undef PG8_STAGE
#undef PG8_LDA
#undef PG8_LDB
#undef PG8_MMA
#undef PG8_WAIT_V
#undef PG8_WAIT_L
#undef PG8_BAR
#undef PG8_SCHED
}


template <class Epi, class Sched, bool ALIGN_EPI = false>
__device__ __forceinline__ void gemm_phase_gather(PG8_LAS unsigned char* lds, const Gemm g, const Sched& S, const Epi& E, const int* rowtok, PG8_LAS int* gtab) {
    const int tid = threadIdx.x, wid = __builtin_amdgcn_readfirstlane(tid >> 6), lane = tid & 63, wr = wid >> 2, wc = wid & 3, fr = lane & 15, fq = lane >> 4;
    const int K = g.K, nt = K / BK;
    unsigned voffB[2], pcol[2]; int prow[2];
#pragma unroll
    for (int i = 0; i < 2; ++i) { int R, C; stage_rc(tid * 16 + i * 8192, R, C); const int Rb = Epi::PERM ? ((R & ~31) + perm32(R & 31)) : R;
        prow[i] = R; pcol[i] = (unsigned)C * 2u; voffB[i] = (unsigned)(Rb * K + C) * 2u; }
    const size_t kstep = (size_t)(BK * 2);
    const size_t hstep = (size_t)HALF * K * 2;
    const size_t tstep = 2 * hstep;
    const unsigned ldsw = (unsigned)wid * 1024u;
    const unsigned rowb = (unsigned)K * 2u;
    const int aoff = lds_byte(wr * 64 + fr, fq * 8), boff = lds_byte(wc * 32 + fr, fq * 8);
#define PG8_SA(b, h) (((b) * 2 + (h)) * HTB)
#define PG8_SB(b, h) ((4 + (b) * 2 + (h)) * HTB)
#define PG8_STAGE(bufoff, gbase, voff) do { _Pragma("unroll") for (int _i = 0; _i < 2; ++_i) \
        __builtin_amdgcn_global_load_lds((const unsigned*)((const char*)(gbase) + (voff)[_i]), (PG8_LAS unsigned*)(lds + (bufoff) + ldsw + _i * 8192), 16, 0, 0); } while (0)
#define PG8_LDA(dst, b, h) do { _Pragma("unroll") for (int m = 0; m < 4; ++m) _Pragma("unroll") for (int k = 0; k < 2; ++k) dst[m][k] = *(const PG8_LAS bf16x8*)(lds + PG8_SA(b, h) + aoff + m * 2048 + k * 1024); } while (0)
#define PG8_LDB(dst, b, h) do { _Pragma("unroll") for (int n = 0; n < 2; ++n) _Pragma("unroll") for (int k = 0; k < 2; ++k) dst[n][k] = *(const PG8_LAS bf16x8*)(lds + PG8_SB(b, h) + boff + n * 2048 + k * 1024); } while (0)
#define PG8_MMA(ai, bj, At, Bt) do { __builtin_amdgcn_s_setprio(1); _Pragma("unroll") for (int m = 0; m < 4; ++m) _Pragma("unroll") for (int n = 0; n < 2; ++n) _Pragma("unroll") for (int k = 0; k < 2; ++k) \
        acc[ai][bj][m][n] = __builtin_amdgcn_mfma_f32_16x16x32_bf16(Bt[n][k], At[m][k], acc[ai][bj][m][n], 0, 0, 0); __builtin_amdgcn_s_setprio(0); } while (0)
#define PG8_WAIT_V(n) asm volatile("s_waitcnt vmcnt(" #n ")" ::: "memory")
#define PG8_WAIT_L(n) asm volatile("s_waitcnt lgkmcnt(" #n ")" ::: "memory")
#define PG8_BAR __builtin_amdgcn_s_barrier()
#define PG8_SCHED __builtin_amdgcn_sched_barrier(0)
    Unit cur, nxt; int ui = 0;
    if (!S.next(0, cur)) return;
    if (tid < 256) gtab[tid] = (tid < cur.a1) ? rowtok[cur.a0 + tid] : 0;
    __syncthreads();
    unsigned cva[2][2], nva[2][2];
#pragma unroll
    for (int h = 0; h < 2; ++h)
#pragma unroll
        for (int i = 0; i < 2; ++i) { cva[h][i] = (unsigned)gtab[h * HALF + prow[i]] * rowb + pcol[i]; nva[h][i] = cva[h][i]; }
    f32x4 acc[2][2][4][2];
#pragma unroll
    for (int a = 0; a < 2; ++a)
#pragma unroll
        for (int b = 0; b < 2; ++b)
#pragma unroll
            for (int m = 0; m < 4; ++m)
#pragma unroll
                for (int n = 0; n < 2; ++n) acc[a][b][m][n] = (f32x4){0.f, 0.f, 0.f, 0.f};
    bf16x8 At[4][2], B0[2][2], B1[2][2];
    const char* gA = (const char*)g.A; const char* cB = (const char*)g.Bt + (size_t)cur.pn * tstep;
    PG8_STAGE(PG8_SB(0, 0), cB, voffB); PG8_STAGE(PG8_SB(0, 1), cB + hstep, voffB); PG8_STAGE(PG8_SA(0, 0), gA, cva[0]); PG8_STAGE(PG8_SA(0, 1), gA, cva[1]);
    if (wr == 1) PG8_BAR;
    PG8_WAIT_V(2); PG8_BAR;
    PG8_STAGE(PG8_SB(1, 0), cB + kstep, voffB); PG8_STAGE(PG8_SA(1, 0), gA + kstep, cva[0]); PG8_STAGE(PG8_SB(1, 1), cB + hstep + kstep, voffB);
    PG8_WAIT_V(6); PG8_BAR;
    for (;;) {
        const bool has_next = S.next(ui + 1, nxt);
        const char* nB = has_next ? (const char*)g.Bt + (size_t)nxt.pn * tstep : cB;
#pragma unroll 1
        for (int t = 0; t < nt; t += 2) {
            const bool last = (t == nt - 2);
            if (t == 0 && has_next && wid < 4) {
                const int r = wid * 64 + lane;
                __builtin_amdgcn_global_load_lds((const unsigned*)(rowtok + nxt.a0 + r), (PG8_LAS unsigned*)(gtab + ((ui + 1) & 1) * 256 + wid * 64), 4, 0, 0);
            }
            if (last && has_next) {
                PG8_LAS int* tb = gtab + ((ui + 1) & 1) * 256;
#pragma unroll
                for (int h = 0; h < 2; ++h)
#pragma unroll
                    for (int i = 0; i < 2; ++i) { const int r = h * HALF + prow[i]; const int tok = (r < nxt.a1) ? tb[r] : 0; nva[h][i] = (unsigned)tok * rowb + pcol[i]; }
            }
            const char* a1 = gA + (size_t)(t + 1) * kstep;
            const char* a2 = last ? gA : gA + (size_t)(t + 2) * kstep; const char* b2 = last ? nB : cB + (size_t)(t + 2) * kstep;
            const char* a3 = a2 + kstep; const char* b3 = b2 + kstep;
            unsigned v2[2][2];
#pragma unroll
            for (int h = 0; h < 2; ++h)
#pragma unroll
                for (int i = 0; i < 2; ++i) v2[h][i] = last ? nva[h][i] : cva[h][i];
            PG8_LDB(B0, 0, 0); PG8_LDB(B1, 0, 1); PG8_SCHED; PG8_LDA(At, 0, 0); PG8_STAGE(PG8_SA(1, 1), a1, cva[1]);
            PG8_WAIT_V(8); PG8_WAIT_L(0); PG8_BAR; PG8_MMA(0, 0, At, B0); PG8_MMA(0, 1, At, B1); PG8_BAR; PG8_SCHED;
            PG8_LDA(At, 0, 1); PG8_STAGE(PG8_SB(0, 0), b2, voffB); PG8_STAGE(PG8_SB(0, 1), b2 + hstep, voffB); PG8_STAGE(PG8_SA(0, 0), a2, v2[0]);
            PG8_WAIT_V(8); PG8_WAIT_L(0); PG8_BAR; PG8_MMA(1, 0, At, B0); PG8_MMA(1, 1, At, B1); PG8_BAR; PG8_SCHED;
            PG8_LDB(B0, 1, 0); PG8_LDB(B1, 1, 1); PG8_SCHED; PG8_LDA(At, 1, 0); PG8_STAGE(PG8_SA(0, 1), a2, v2[1]);
            PG8_WAIT_V(8); PG8_WAIT_L(0); PG8_BAR; PG8_MMA(0, 0, At, B0); PG8_MMA(0, 1, At, B1); PG8_BAR; PG8_SCHED;
            PG8_LDA(At, 1, 1); PG8_STAGE(PG8_SB(1, 0), b3, voffB); PG8_STAGE(PG8_SB(1, 1), b3 + hstep, voffB); PG8_STAGE(PG8_SA(1, 0), a3, v2[0]);
            PG8_WAIT_V(8); PG8_WAIT_L(0); PG8_BAR; PG8_MMA(1, 0, At, B0); PG8_MMA(1, 1, At, B1); PG8_BAR; PG8_SCHED;
        }
        if constexpr (ALIGN_EPI) { if (wr == 0) PG8_BAR; }
        E(acc, cur, wr, wc, fr, fq);
        if (!has_next) break;
#pragma unroll
        for (int a = 0; a < 2; ++a)
#pragma unroll
            for (int b = 0; b < 2; ++b)
#pragma unroll
                for (int m = 0; m < 4; ++m)
#pragma unroll
                    for (int n = 0; n < 2; ++n) acc[a][b][m][n] = (f32x4){0.f, 0.f, 0.f, 0.f};
        cur = nxt; cB = nB; ++ui;
#pragma unroll
        for (int h = 0; h < 2; ++h)
#pragma unroll
            for (int i = 0; i < 2; ++i) cva[h][i] = nva[h][i];
        if constexpr (ALIGN_EPI) { if (wr == 1) PG8_BAR; }
    }
    PG8_WAIT_V(0);
    if constexpr (!ALIGN_EPI) { if (wr == 0) PG8_BAR; }
    PG8_BAR;
#undef PG8_SA
#undef PG8_SB
#undef PG8_STAGE
#undef PG8_LDA
#undef PG8_LDB
#undef PG8_MMA
#undef PG8_WAIT_V
#undef PG8_WAIT_L
#undef PG8_BAR
#undef PG8_SCHED
}

}


constexpr int NWAVES = 8;
constexpr int BATCH = 2, SEQ = 8192, D = 1024, M = BATCH * SEQ;
constexpr int NSH = 1792, DIN = 2816, DR = 512, DSG = 512, NH = 8, HS = 64;
constexpr int NEXP = 64, TOPK = 8, DE = 256, ECAP = 16384;
constexpr int MOD_KC = 16;
constexpr float RMS_EPS = 1e-6f;

constexpr size_t MiB = 1u << 20;
constexpr size_t WS_CTL = 0, CTL_ZERO_BYTES = 128 * 1024;
constexpr size_t WS_WIN   = 1 * MiB;
constexpr size_t WS_WOUT  = WS_WIN + (size_t)DIN * D * 2;
constexpr size_t WS_WS13  = WS_WOUT + (size_t)D * D * 2;
constexpr size_t WS_WS2   = WS_WS13 + (size_t)768 * D * 2;
constexpr size_t WS_WLORA = WS_WS2 + (size_t)D * 256 * 2;
constexpr size_t WS_WSP   = WS_WLORA + (size_t)1536 * 256 * 2;
constexpr size_t WS_MODP  = WS_WSP + (size_t)8 * 128 * 128 * 2;
constexpr size_t WS_MODF  = WS_MODP + (size_t)MOD_KC * 2 * 6144 * 4;
constexpr size_t WS_BONUS = WS_MODF + (size_t)2 * 6144 * 4;
constexpr size_t WS_SMALL_END = WS_BONUS + (size_t)M * 8 * 4;
static_assert(WS_SMALL_END <= 14 * MiB, "small region");
constexpr size_t WS_PROJ = 14 * MiB;
constexpr size_t WS_LW   = 102 * MiB;
constexpr size_t WS_AB   = 118 * MiB;
constexpr size_t WS_GB   = 134 * MiB;
constexpr size_t WS_HBUF = 150 * MiB;
constexpr size_t WS_LIN  = 150 * MiB;
constexpr size_t WS_AH   = 150 * MiB;
constexpr size_t WS_UH   = 166 * MiB;
constexpr size_t WS_PM   = 182 * MiB;
constexpr size_t WS_QM   = 198 * MiB;
constexpr size_t WS_H0   = 230 * MiB;
constexpr size_t WS_YCAT = 246 * MiB;
constexpr size_t WS_WE2  = 14 * MiB;
constexpr size_t WS_LOGIT= 46 * MiB;
constexpr size_t WS_ROWTOK = 50 * MiB;
constexpr size_t WS_SLOT = 54 * MiB;
constexpr size_t WS_WT   = 55 * MiB;
constexpr size_t WS_ACT  = 56 * MiB;
constexpr size_t WS_ACTS = 128 * MiB;
constexpr size_t WS_WE13 = 136 * MiB;
constexpr size_t WS_H2   = 200 * MiB;
constexpr size_t WS_Y    = 136 * MiB;
constexpr size_t WS_SH   = 264 * MiB;
constexpr size_t WS_END  = 296 * MiB;
constexpr int ACT_ROWS = 147456;
constexpr int CW_BAR = 4096;
constexpr int CW_CVQ = 16256;
constexpr int CW_SGUQ = 16320;
constexpr int CW_ECNT = 16384;

constexpr int RING_OFF = 0, RING_BYTES = 131072;
constexpr int LDSX_OFF = RING_BYTES;
constexpr int LX_GTAB = LDSX_OFF;
constexpr int LX_TTAB = LDSX_OFF + 2048;
constexpr int LX_ECNT = LDSX_OFF + 2048 + 2816;
constexpr int LDSCTL_OFF = RING_BYTES + 12288, MISC_OFF = LDSCTL_OFF + 320;
constexpr int LDS_BYTES = 147456;
static_assert(MISC_OFF + 128 <= LDS_BYTES, "LDS map");

#define GAS __attribute__((address_space(1)))
#define LAS __attribute__((address_space(3)))
typedef unsigned short bf16;
typedef unsigned v4u __attribute__((ext_vector_type(4)));
typedef unsigned v2u __attribute__((ext_vector_type(2)));
typedef float f32x4 __attribute__((ext_vector_type(4)));
typedef short bf16x8 __attribute__((ext_vector_type(8)));
typedef GAS unsigned gu32;
#define RLX_AGENT __ATOMIC_RELAXED, __HIP_MEMORY_SCOPE_AGENT
#define LDS_WAIT() asm volatile("s_waitcnt lgkmcnt(0)" ::: "memory")
#define VM_WAIT() asm volatile("s_waitcnt vmcnt(0)" ::: "memory")
#define LBAR() do { asm volatile("s_waitcnt lgkmcnt(0)" ::: "memory"); __builtin_amdgcn_s_barrier(); asm volatile("" ::: "memory"); } while (0)
__device__ __forceinline__ unsigned f2bf(float f) { unsigned u = __builtin_bit_cast(unsigned, f); return (u + 0x7fffu + ((u >> 16) & 1u)) >> 16; }
__device__ __forceinline__ unsigned pk2(float lo, float hi) { return f2bf(lo) | (f2bf(hi) << 16); }
__device__ __forceinline__ float bf2f(unsigned short h) { return __builtin_bit_cast(float, (unsigned)h << 16); }
__device__ __forceinline__ float bflo(unsigned w) { return __builtin_bit_cast(float, w << 16); }
__device__ __forceinline__ float bfhi(unsigned w) { return __builtin_bit_cast(float, w & 0xffff0000u); }
__device__ __forceinline__ float fsig(float x) { return __builtin_amdgcn_rcpf(1.0f + __expf(-x)); }
__device__ __forceinline__ float fgelu(float x) { return x * fsig(1.5957691216f * (x + 0.044715f * x * x * x)); }
__device__ __forceinline__ float wave_sum(float v) {
#pragma unroll
    for (int o = 1; o < 64; o <<= 1) v += __shfl_xor(v, o);
    return v;
}

#define XB_TMO      128
#define XB_XCNT(j)  (256  + 64 * (j))
#define XB_XSUB(j)  (1280 + 64 * (j))
#define XB_XGEN(j)  (2304 + 64 * (j))
#define XB_TOP      3328
#define XB_TOPGEN   3392
#define XCD_BAR_WORDS 3456
#define XB_SPIN_CAP (1u << 18)
__device__ __forceinline__ unsigned xb_ld(unsigned* p)              { return __hip_atomic_load(p, __ATOMIC_RELAXED, __HIP_MEMORY_SCOPE_AGENT); }
__device__ __forceinline__ unsigned xb_add(unsigned* p, unsigned v) { return __hip_atomic_fetch_add(p, v, __ATOMIC_RELAXED, __HIP_MEMORY_SCOPE_AGENT); }
__device__ __forceinline__ unsigned xb_xcc_id() { return (unsigned)__builtin_amdgcn_s_getreg((3 << 11) | 20) & 0xFu; }
#define XB_SPIN(cond, bar) do { unsigned _sp = 0; while (cond) { __builtin_amdgcn_s_sleep(1); \
    if ((++_sp & 255u) == 0u) { if (xb_ld(&(bar)[XB_TMO])) break; if (_sp > XB_SPIN_CAP) { atomicAdd(&(bar)[XB_TMO], 1u); break; } } } } while (0)
struct XcdBarrier { unsigned* bar; unsigned x; volatile LAS unsigned* st; };
__device__ __forceinline__ XcdBarrier xcd_barrier_post(unsigned* bar, volatile LAS unsigned* st) {
    XcdBarrier b; b.bar = bar; b.x = xb_xcc_id(); b.st = st;
    if (threadIdx.x == 0) (void)xb_add(&bar[XB_XCNT(b.x)], 1u);
    return b;
}
__device__ __forceinline__ void xcd_barrier_complete(unsigned* bar, unsigned x, unsigned& nloc, unsigned& nx) {
    const unsigned G = gridDim.x * gridDim.y * gridDim.z;
    unsigned sum, cnt, mine, sp = 0u;
    for (;;) {
        sum = 0u; cnt = 0u; mine = 0u;
#pragma unroll
        for (unsigned j = 0; j < 16; ++j) { const unsigned c = xb_ld(&bar[XB_XCNT(j)]); sum += c; cnt += (c > 0u) ? 1u : 0u; mine = (j == x) ? c : mine; }
        if (sum == G) break;
        __builtin_amdgcn_s_sleep(1);
        if ((++sp & 255u) == 0u) { if (xb_ld(&bar[XB_TMO])) break; if (sp > XB_SPIN_CAP) { atomicAdd(&bar[XB_TMO], 1u); break; } }
    }
    nloc = mine > 0u ? mine : 1u; nx = cnt > 0u ? cnt : 1u;
}
__device__ __forceinline__ void xcd_barrier(const XcdBarrier& b) {
    asm volatile("s_waitcnt vmcnt(0)" ::: "memory");
    __syncthreads();
    if (threadIdx.x == 0) {
        unsigned* bar = b.bar;
        __builtin_amdgcn_s_waitcnt(0);
        unsigned nloc = b.st[0], nx = b.st[1];
        if (nloc == 0u) { xcd_barrier_complete(bar, b.x, nloc, nx); b.st[0] = nloc; b.st[1] = nx; }
        const unsigned old = xb_add(&bar[XB_XSUB(b.x)], 1u);
        const unsigned gen = old / nloc;
        if (old + 1u == (gen + 1u) * nloc) {
            __builtin_amdgcn_fence(__ATOMIC_RELEASE, "agent");
            asm volatile("s_waitcnt vmcnt(0)" ::: "memory");
            const unsigned og = xb_add(&bar[XB_TOP], 1u);
            const unsigned tg = og / nx;
            if (og + 1u == (tg + 1u) * nx) xb_add(&bar[XB_TOPGEN], 1u);
            else XB_SPIN(xb_ld(&bar[XB_TOPGEN]) == tg, bar);
            __builtin_amdgcn_fence(__ATOMIC_ACQUIRE, "agent");
            xb_add(&bar[XB_XGEN(b.x)], 1u);
            asm volatile("s_waitcnt vmcnt(0)" ::: "memory");
        } else {
            XB_SPIN(xb_ld(&bar[XB_XGEN(b.x)]) == gen, bar);
            __builtin_amdgcn_fence(__ATOMIC_ACQUIRE, "agent");
            asm volatile("s_waitcnt vmcnt(0)" ::: "memory");
        }
    }
    __syncthreads();
}

struct Frame {
    LAS unsigned char* lds;
    volatile LAS unsigned* MISC;
    gu32* ctl;
    int tid, lane, wave;
    int vcu, G;
    unsigned char* ws;
    float* out;
};

__device__ __forceinline__ void transpose_item(const float* W, int K, int N, bf16* WT, int k0, int n0, int dst_row0, LAS float* scr, int lane) {
#pragma unroll 8
    for (int i = 0; i < 32; ++i) { const int kk = 2 * i + (lane >> 5); scr[kk * 33 + (lane & 31)] = W[(size_t)(k0 + kk) * N + n0 + (lane & 31)]; }
    LDS_WAIT(); asm volatile("" ::: "memory");
    const int c = lane & 7;
#pragma unroll
    for (int j = 0; j < 4; ++j) { const int n = (lane >> 3) + 8 * j; const LAS float* s = scr + (8 * c) * 33 + n;
        v4u o; o.x = pk2(s[0 * 33], s[1 * 33]); o.y = pk2(s[2 * 33], s[3 * 33]); o.z = pk2(s[4 * 33], s[5 * 33]); o.w = pk2(s[6 * 33], s[7 * 33]);
        *(GAS v4u*)(WT + (size_t)(dst_row0 + n) * K + k0 + 8 * c) = o; }
    LDS_WAIT(); asm volatile("" ::: "memory");
}
__device__ __forceinline__ int swiglu_row(int n, int which) { return (n >> 7) * 256 + which * 128 + (n & 127); }


struct Args { const float* in[32]; float* out; unsigned char* ws; int ph_lo, ph_hi, li, pad; };

__device__ __forceinline__ void p0_prologue(Frame& F, const Args& a) {
    LAS float* scr = (LAS float*)(F.lds + RING_OFF + F.wave * 16384);
    const int gw = F.vcu * NWAVES + F.wave, NGW = F.G * NWAVES;
    bf16* Win_t = (bf16*)(F.ws + WS_WIN); bf16* Wout_t = (bf16*)(F.ws + WS_WOUT); bf16* WS13 = (bf16*)(F.ws + WS_WS13); bf16* WS2 = (bf16*)(F.ws + WS_WS2);
    constexpr int I_IN = 16 * 88, I_OUT = 16 * 32, I_S1 = 16 * 8, I_R = 16 * 2, I_S2 = 4 * 32;
    constexpr int NITEMS = I_IN + I_OUT + 2 * I_S1 + I_R + I_S2;
    for (int it = gw; it < NITEMS; it += NGW) {
        int r = it;
        if (r < I_IN) { const int kb = r / 88, nb = r % 88; transpose_item(a.in[5], 1024, DIN, Win_t, 64 * kb, 32 * nb, 32 * nb, scr, F.lane); continue; } r -= I_IN;
        if (r < I_OUT) { const int kb = r / 32, nb = r % 32;
            transpose_item(a.in[21], 1024, 1024, Wout_t, 64 * kb, 32 * nb, 32 * nb, scr, F.lane); continue; } r -= I_OUT;
        if (r < I_S1) { const int kb = r / 8, nb = r % 8; transpose_item(a.in[28], 1024, 256, WS13, 64 * kb, 32 * nb, swiglu_row(32 * nb, 0), scr, F.lane); continue; } r -= I_S1;
        if (r < I_S1) { const int kb = r / 8, nb = r % 8; transpose_item(a.in[29], 1024, 256, WS13, 64 * kb, 32 * nb, swiglu_row(32 * nb, 1), scr, F.lane); continue; } r -= I_S1;
        if (r < I_R) { const int kb = r / 2, nb = r % 2; transpose_item(a.in[23], 1024, 64, WS13, 64 * kb, 32 * nb, 512 + 32 * nb, scr, F.lane); continue; } r -= I_R;
        { const int kb = r / 32, nb = r % 32; transpose_item(a.in[30], 256, 1024, WS2, 64 * kb, 32 * nb, 32 * nb, scr, F.lane); }
    }
    { bf16* Wl = (bf16*)(F.ws + WS_WLORA); const float* wd = a.in[8]; const float* wa = a.in[10]; const float* wg = a.in[11];
      for (int idx = (int)blockIdx.x * 512 + F.tid; idx < 1536 * 256; idx += F.G * 512) {
          const int n = idx >> 8, k = idx & 255; float v = 0.f;
          if (n < 512) { if (k < 64) v = wd[k * 512 + n]; }
          else if (n < 1024) { if (k >= 64 && k < 128) v = wa[(k - 64) * 512 + (n - 512)]; }
          else { if (k >= 128) v = wg[(k - 128) * 512 + (n - 1024)]; }
          Wl[idx] = (bf16)f2bf(v); } }
    { bf16* Wsp = (bf16*)(F.ws + WS_WSP); const float* w = a.in[19];
      for (int idx = (int)blockIdx.x * 512 + F.tid; idx < 8 * 128 * 128; idx += F.G * 512) {
          const int t = (idx >> 7) & 127, s = idx & 127; const float v = (t < 64 && s >= 64) ? 0.f : w[idx]; Wsp[idx] = (bf16)f2bf(v); } }
    { float* modp = (float*)(F.ws + WS_MODP); const float* c = a.in[1]; const float* wada = a.in[2];
      for (int it = gw; it < 96 * MOD_KC; it += NGW) {
          const int cg = it % 96, kc = it / 96, j = cg * 64 + F.lane; float a0 = 0.f, a1 = 0.f;
#pragma unroll 8
          for (int kk = 0; kk < 64; ++kk) { const int k = kc * 64 + kk; const float w = wada[(size_t)k * 6144 + j]; const float c0 = c[k], c1 = c[1024 + k];
              a0 += c0 * fsig(c0) * w; a1 += c1 * fsig(c1) * w; }
          modp[(size_t)(kc * 2 + 0) * 6144 + j] = a0; modp[(size_t)(kc * 2 + 1) * 6144 + j] = a1; } }
}

__device__ __forceinline__ void norm_row_to_bf16(const float* xrow, bf16* orow, const LAS float* ga, const LAS float* sh, int lane) {
    const GAS f32x4* xr = (const GAS f32x4*)xrow + lane;
    f32x4 v[4]; float s = 0.f;
#pragma unroll
    for (int j = 0; j < 4; ++j) { v[j] = xr[64 * j]; s += (v[j].x * v[j].x + v[j].y * v[j].y) + (v[j].z * v[j].z + v[j].w * v[j].w); }
    const float rstd = 1.f / sqrtf(wave_sum(s) * (1.f / D) + RMS_EPS);
    GAS unsigned long long* o8 = (GAS unsigned long long*)orow + lane;
#pragma unroll
    for (int j = 0; j < 4; ++j) { const f32x4 g = *(const LAS f32x4*)(ga + 4 * lane + 256 * j), b = *(const LAS f32x4*)(sh + 4 * lane + 256 * j);
        const f32x4 o = v[j] * rstd * g + b;
        o8[64 * j] = (unsigned long long)pk2(o.x, o.y) | ((unsigned long long)pk2(o.z, o.w) << 32); }
}

__device__ __forceinline__ void p1_h(Frame& F, const Args& a) {
    LAS float* ga = (LAS float*)(F.lds);
    LAS float* sh = (LAS float*)(F.lds + 8192);
    const float* modp = (const float*)(F.ws + WS_MODP); const float* bada = a.in[3]; const float* g1n = a.in[4];
    for (int idx = F.tid; idx < 2048; idx += 512) {
        const int b = idx >> 10, k = idx & 1023; float s0 = bada[k], s1 = bada[1024 + k];
#pragma unroll
        for (int kc = 0; kc < MOD_KC; ++kc) { s0 += modp[(size_t)(kc * 2 + b) * 6144 + k]; s1 += modp[(size_t)(kc * 2 + b) * 6144 + 1024 + k]; }
        sh[idx] = s0; ga[idx] = g1n[k] * (1.f + s1);
    }
    { float* modf = (float*)(F.ws + WS_MODF);
      for (int idx = (int)blockIdx.x * 512 + F.tid; idx < 2 * 6144; idx += F.G * 512) {
          const int b = idx / 6144, j = idx % 6144; float s = bada[j];
#pragma unroll
          for (int kc = 0; kc < MOD_KC; ++kc) s += modp[(size_t)(kc * 2 + b) * 6144 + j];
          modf[idx] = s; } }
    LDS_WAIT(); __syncthreads();
    const int gw = F.vcu * NWAVES + F.wave, NGW = F.G * NWAVES;
    const float* x = a.in[0]; bf16* H = (bf16*)(F.ws + WS_HBUF);
    for (int m = gw; m < M; m += NGW) { const int b = m >> 13; norm_row_to_bf16(x + (size_t)m * D, H + (size_t)m * D, ga + b * 1024, sh + b * 1024, F.lane); }
    __syncthreads();
}

__device__ __forceinline__ void p9_h2(Frame& F, const Args& a) {
    LAS float* ga = (LAS float*)(F.lds);
    LAS float* sh = (LAS float*)(F.lds + 8192);
    const float* modf = (const float*)(F.ws + WS_MODF); const float* g2n = a.in[22];
    for (int idx = F.tid; idx < 2048; idx += 512) { const int b = idx >> 10, k = idx & 1023; sh[idx] = modf[b * 6144 + 3072 + k]; ga[idx] = g2n[k] * (1.f + modf[b * 6144 + 4096 + k]); }
    LDS_WAIT(); __syncthreads();
    const int gw = F.vcu * NWAVES + F.wave, NGW = F.G * NWAVES;
    const float* x1 = F.out; bf16* H = (bf16*)(F.ws + WS_H2);
    for (int m = gw; m < M; m += NGW) { const int b = m >> 13; norm_row_to_bf16(x1 + (size_t)m * D, H + (size_t)m * D, ga + b * 1024, sh + b * 1024, F.lane); }
    __syncthreads();
}

constexpr int VT_STRIDE = 136;
__device__ __forceinline__ void gelu8(const v4u q, float (&g)[8]) { g[0] = fgelu(bflo(q.x)); g[1] = fgelu(bfhi(q.x)); g[2] = fgelu(bflo(q.y)); g[3] = fgelu(bfhi(q.y)); g[4] = fgelu(bflo(q.z)); g[5] = fgelu(bfhi(q.z)); g[6] = fgelu(bflo(q.w)); g[7] = fgelu(bfhi(q.w)); }
__device__ __forceinline__ void sgu_item(Frame& F, const Args& a, int item) {
    const int nb = item >> 2, hp = item & 3, m0 = nb * 128;
    const bf16* proj = (const bf16*)(F.ws + WS_PROJ); bf16* Ycat = (bf16*)(F.ws + WS_YCAT); const bf16* Wsp = (const bf16*)(F.ws + WS_WSP);
    const float* lng = a.in[17]; const float* lnb = a.in[18]; const float* bsp = a.in[20];
    LAS float* stats = (LAS float*)(F.lds);
    LAS bf16* Vt = (LAS bf16*)(F.lds + 1024);
    int lane_ = F.lane, w_ = F.wave; asm volatile("" : "+v"(lane_)); asm volatile("" : "+s"(w_));
    const int lane = lane_, w = w_, fr = lane & 15, fq = lane >> 4; const int nks = (w < 4) ? 2 : 4;
    v4u srow[16];
#pragma unroll
    for (int i = 0; i < 16; ++i) srow[i] = *(const GAS v4u*)(proj + (size_t)(m0 + w * 16 + i) * DIN + NSH + 512 + 8 * lane);
    v4u vpc[4];
#pragma unroll
    for (int j = 0; j < 4; ++j) { const int step = w + 8 * j, s = (step & 1) * 64 + lane, chunk = step >> 1; vpc[j] = *(const GAS v4u*)(proj + (size_t)(m0 + s) * DIN + NSH + 512 + hp * 128 + chunk * 8); }
    bf16x8 af[2][4];
#pragma unroll
    for (int hh = 0; hh < 2; ++hh)
#pragma unroll
        for (int ks = 0; ks < 4; ++ks) af[hh][ks] = (ks < nks) ? *(const GAS bf16x8*)(Wsp + (size_t)((hp * 2 + hh) * 128 + 16 * w + fr) * 128 + 32 * ks + 8 * fq) : (bf16x8){0, 0, 0, 0, 0, 0, 0, 0};
    unsigned short uu[2][4][4]; float bias[2][4];
#pragma unroll
    for (int hh = 0; hh < 2; ++hh)
#pragma unroll
        for (int reg = 0; reg < 4; ++reg) { const int t = 16 * w + 4 * fq + reg; bias[hh][reg] = bsp[(hp * 2 + hh) * 128 + t];
#pragma unroll
            for (int ni = 0; ni < 4; ++ni) uu[hh][reg][ni] = proj[(size_t)(m0 + t) * DIN + NSH + (hp * 2 + hh) * 64 + 16 * ni + fr]; }
#pragma unroll
    for (int i = 0; i < 16; ++i) { const int t = w * 16 + i; float g[8]; gelu8(srow[i], g);
        float s = 0.f, ss = 0.f;
#pragma unroll
        for (int j = 0; j < 8; ++j) { s += g[j]; ss += g[j] * g[j]; }
        s = wave_sum(s); ss = wave_sum(ss);
        const float mean = s * (1.f / 512.f), var = fmaxf(ss * (1.f / 512.f) - mean * mean, 0.f);
        if (lane == 0) { stats[2 * t] = mean; stats[2 * t + 1] = 1.f / sqrtf(var + 1e-5f); } }
    LBAR();
#pragma unroll
    for (int j = 0; j < 4; ++j) { const int step = w + 8 * j, s = (step & 1) * 64 + lane, chunk = step >> 1; const int ch0 = hp * 128 + chunk * 8;
        const float mean = stats[2 * s], rstd = stats[2 * s + 1]; float g[8]; gelu8(vpc[j], g);
#pragma unroll
        for (int jj = 0; jj < 8; ++jj) { const float v = (g[jj] - mean) * rstd * lng[ch0 + jj] + lnb[ch0 + jj]; Vt[(chunk * 8 + jj) * VT_STRIDE + s] = (bf16)f2bf(v); } }
    LBAR();
    f32x4 acc[2][4];
#pragma unroll
    for (int hh = 0; hh < 2; ++hh)
#pragma unroll
        for (int ni = 0; ni < 4; ++ni) acc[hh][ni] = (f32x4){0.f, 0.f, 0.f, 0.f};
#pragma unroll
    for (int hh = 0; hh < 2; ++hh)
#pragma unroll
        for (int ks = 0; ks < 4; ++ks) { if (ks < nks) {
#pragma unroll
            for (int ni = 0; ni < 4; ++ni) { const bf16x8 bfr = *(const LAS bf16x8*)(Vt + (hh * 64 + 16 * ni + fr) * VT_STRIDE + 32 * ks + 8 * fq);
                acc[hh][ni] = __builtin_amdgcn_mfma_f32_16x16x32_bf16(af[hh][ks], bfr, acc[hh][ni], 0, 0, 0); } } }
#pragma unroll
    for (int hh = 0; hh < 2; ++hh) { const int h = hp * 2 + hh;
#pragma unroll
        for (int reg = 0; reg < 4; ++reg) { const int t = 16 * w + 4 * fq + reg;
#pragma unroll
            for (int ni = 0; ni < 4; ++ni) { const int ch = h * 64 + 16 * ni + fr;
                Ycat[(size_t)(m0 + t) * D + 512 + ch] = (bf16)f2bf(fgelu(bf2f(uu[hh][reg][ni])) * (acc[hh][ni][reg] + bias[hh][reg])); } } }
    LBAR();
}

__device__ __forceinline__ void final_norm_rows(Frame& F, const Args& a) {
    const int gw = F.vcu * NWAVES + F.wave, NGW = F.G * NWAVES; const float* nf = a.in[31];
    for (int m = gw; m < M; m += NGW) {
        GAS f32x4* xr = (GAS f32x4*)(F.out + (size_t)m * D) + F.lane; f32x4 v[4]; float s = 0.f;
#pragma unroll
        for (int j = 0; j < 4; ++j) { v[j] = xr[64 * j]; s += (v[j].x * v[j].x + v[j].y * v[j].y) + (v[j].z * v[j].z + v[j].w * v[j].w); }
        const float rstd = 1.f / sqrtf(wave_sum(s) * (1.f / D) + RMS_EPS);
#pragma unroll
        for (int j = 0; j < 4; ++j) { const f32x4 g = *(const f32x4*)(nf + 4 * F.lane + 256 * j); xr[64 * j] = v[j] * rstd * g; }
    }
}


__device__ __forceinline__ void convert_w13(Frame& F, const Args& a) {
    LAS float* scr = (LAS float*)(F.lds + RING_OFF + F.wave * 16384);
    const int gw = F.vcu * NWAVES + F.wave, NGW = F.G * NWAVES;
    bf16* WE13 = (bf16*)(F.ws + WS_WE13);
    for (int it = gw; it < NEXP * 256; it += NGW) {
        const int e = it >> 8, r = it & 255, which = r >> 7, q = r & 127, kb = q >> 3, nb = q & 7;
        transpose_item(a.in[25 + which] + (size_t)e * 262144, 1024, 256, WE13 + (size_t)e * 524288, 64 * kb, 32 * nb, swiglu_row(32 * nb, which), scr, F.lane);
    }
    __syncthreads();
}
__device__ __forceinline__ void convert_w2_queue(Frame& F, const Args& a) {
    LAS float* scr = (LAS float*)(F.lds + RING_OFF + F.wave * 16384);
    bf16* WE2 = (bf16*)(F.ws + WS_WE2);
    for (;;) {
        unsigned base = 0; if (F.lane == 0) base = __hip_atomic_fetch_add((unsigned*)(F.ctl + CW_CVQ), 4u, __ATOMIC_RELAXED, __HIP_MEMORY_SCOPE_AGENT);
        base = (unsigned)__builtin_amdgcn_readfirstlane((int)base);
        if (base >= (unsigned)(NEXP * 128)) break;
#pragma unroll 1
        for (int i = 0; i < 4; ++i) { const int it = (int)base + i, e = it >> 7, q = it & 127, kb = q >> 5, nb = q & 31;
            transpose_item(a.in[27] + (size_t)e * 262144, 256, 1024, WE2 + (size_t)e * 262144, 64 * kb, 32 * nb, 32 * nb, scr, F.lane); }
    }
    __syncthreads();
}

__device__ __forceinline__ float oct_max_f(float v) { v = fmaxf(v, __shfl_xor(v, 1)); v = fmaxf(v, __shfl_xor(v, 2)); v = fmaxf(v, __shfl_xor(v, 4)); return v; }
__device__ __forceinline__ void p11_route(Frame& F, const Args& a, int item0, int nitems) {
    const float* logits = (const float*)(F.ws + WS_LOGIT); const float* ebias = a.in[24];
    int* rowtok = (int*)(F.ws + WS_ROWTOK); int* slot = (int*)(F.ws + WS_SLOT); float* wt = (float*)(F.ws + WS_WT);
    unsigned* ecnt = (unsigned*)(F.ctl + CW_ECNT);
    LAS unsigned* lcnt = (LAS unsigned*)(F.lds);
    LAS unsigned* lbase = lcnt + 64;
    const int lane = F.lane, g = lane & 7, tl = lane >> 3; (void)nitems;
    if (F.tid < 64) lcnt[F.tid] = 0u;
    LDS_WAIT(); __syncthreads();
    int me[4]; float mw[4]; unsigned mr[4];
    float eb[8];
#pragma unroll
    for (int j = 0; j < 8; ++j) eb[j] = ebias[8 * g + j];
#pragma unroll
    for (int pass = 0; pass < 4; ++pass) {
        const int tok = item0 * 64 + pass * 64 + F.wave * 8 + tl;
        const f32x4 q0 = *(const GAS f32x4*)(logits + (size_t)tok * 64 + 8 * g), q1 = *(const GAS f32x4*)(logits + (size_t)tok * 64 + 8 * g + 4);
        float b[8]; b[0] = fsig(q0.x) + eb[0]; b[1] = fsig(q0.y) + eb[1]; b[2] = fsig(q0.z) + eb[2]; b[3] = fsig(q0.w) + eb[3]; b[4] = fsig(q1.x) + eb[4]; b[5] = fsig(q1.y) + eb[5]; b[6] = fsig(q1.z) + eb[6]; b[7] = fsig(q1.w) + eb[7];
        float m1 = -INFINITY, m2 = -INFINITY;
#pragma unroll
        for (int j = 0; j < 8; ++j) { const float v = b[j]; if (v > m1) { m2 = m1; m1 = v; } else if (v > m2) { m2 = v; } }
        const float gs = m1 + m2;
        int rank = 0;
#pragma unroll
        for (int x = 1; x < 8; ++x) { const float o = __shfl_xor(gs, x); const int og = g ^ x; rank += (o > gs || (o == gs && og < g)) ? 1 : 0; }
        const bool allowed = rank < 4;
#pragma unroll
        for (int j = 0; j < 8; ++j) if (!allowed) b[j] = -INFINITY;
        int my_e = 0; float my_s = 0.f, ssum = 0.f;
#pragma unroll
        for (int r = 0; r < 8; ++r) {
            float lv = b[0]; int li = 0;
#pragma unroll
            for (int j = 1; j < 8; ++j) if (b[j] > lv) { lv = b[j]; li = j; }
            const float best = oct_max_f(lv);
            int cand = (lv == best) ? g : 8; cand = min(cand, __shfl_xor(cand, 1)); cand = min(cand, __shfl_xor(cand, 2)); cand = min(cand, __shfl_xor(cand, 4));
            const int src = (lane & ~7) | cand; const int bj = __shfl(li, src); const int be = 8 * cand + bj;
            float ebj = eb[0];
#pragma unroll
            for (int j = 1; j < 8; ++j) ebj = (li == j) ? eb[j] : ebj;
            const float bs = __shfl(lv - ebj, src);
            if (g == cand) {
#pragma unroll
                for (int j = 0; j < 8; ++j) if (li == j) b[j] = -INFINITY; }
            ssum += bs; if (g == r) { my_e = be; my_s = bs; }
        }
        me[pass] = my_e; mw[pass] = my_s * (2.5f / ssum);
        mr[pass] = __hip_atomic_fetch_add(lcnt + my_e, 1u, __ATOMIC_RELAXED, __HIP_MEMORY_SCOPE_WORKGROUP);
    }
    LDS_WAIT(); __syncthreads();
    if (F.tid < 64) { const unsigned n = lcnt[F.tid]; unsigned base = 0u; if (n) base = __hip_atomic_fetch_add(ecnt + F.tid, n, __ATOMIC_RELAXED, __HIP_MEMORY_SCOPE_AGENT); lbase[F.tid] = base; }
    LDS_WAIT(); __syncthreads();
#pragma unroll
    for (int pass = 0; pass < 4; ++pass) { const int tok = item0 * 64 + pass * 64 + F.wave * 8 + tl; const unsigned pos = lbase[me[pass]] + mr[pass];
        rowtok[(size_t)me[pass] * ECAP + pos] = tok; slot[(size_t)tok * 8 + g] = (me[pass] << 16) | (int)pos; wt[(size_t)tok * 8 + g] = mw[pass]; }
    LDS_WAIT(); __syncthreads();
}

__device__ __forceinline__ int build_tile_table(Frame& F) {
    LAS int* ttab = (LAS int*)(F.lds + LX_TTAB); LAS int* ecl = (LAS int*)(F.lds + LX_ECNT); LAS int* ecs = ecl + 64; LAS int* ntl = ecl + 128;
    const unsigned* ecnt = (const unsigned*)(F.ctl + CW_ECNT);
    if (F.tid < 64) ecl[F.tid] = (int)__hip_atomic_load(ecnt + F.tid, __ATOMIC_RELAXED, __HIP_MEMORY_SCOPE_AGENT);
    LDS_WAIT(); __syncthreads();
    if (F.tid < 64) { int ts = 0, cs = 0;
        for (int e = 0; e < F.tid; ++e) { const int c = ecl[e]; ts += (c + 255) >> 8; cs += c; }
        const int c = ecl[F.tid], nt = (c + 255) >> 8; ecs[F.tid] = cs;
        for (int j = 0; j < nt; ++j) ttab[ts + j] = (F.tid << 16) | j;
        if (F.tid == 63) ntl[0] = ts + nt; }
    LDS_WAIT(); __syncthreads();
    return __builtin_amdgcn_readfirstlane(ntl[0]);
}
struct MoeOrder {
    const LAS int* ttab; const LAS int* ecl; const LAS int* ecs; int nunits, npn, pn_base, pn_per_e, up, G, c;
    __device__ __forceinline__ bool next(int i, pg8::Unit& u) const {
        const int L = i * G + c; if (L >= nunits) return false;
        const int q = L / npn, pl = L - q * npn;
        const int ent = __builtin_amdgcn_readfirstlane(ttab[q]); const int e = ent >> 16, j = ent & 0xffff;
        const int cn = __builtin_amdgcn_readfirstlane(ecl[e]), cs = __builtin_amdgcn_readfirstlane(ecs[e]);
        u.pm = q; u.pn = e * pn_per_e + pn_base + pl; const int v = cn - j * 256; u.a1 = v < 256 ? v : 256;
        u.a0 = up ? (e * ECAP + j * 256) : (cs + j * 256); u.a2 = pl; return true;
    }
    __device__ __forceinline__ void a_ready(const pg8::Unit&) const {}
    __device__ __forceinline__ void done(const pg8::Unit&) const {}
};

struct LightOrder {
    int li, nl;
    __device__ __forceinline__ bool next(int i, pg8::Unit& u) const {
        if (li < 0) return false; const int L = i * nl + li; if (L >= 256) return false;
        u.pm = L >> 2; u.pn = L & 3; u.a0 = 0; u.a1 = 256; u.a2 = 0; return true; }
    __device__ __forceinline__ void a_ready(const pg8::Unit&) const {}
    __device__ __forceinline__ void done(const pg8::Unit&) const {}
};

__device__ __forceinline__ void combine_all(Frame& F, const Args& a) {
    const LAS int* ecs = (const LAS int*)(F.lds + LX_ECNT) + 64;
    const int* slot = (const int*)(F.ws + WS_SLOT); const float* wt = (const float*)(F.ws + WS_WT); const unsigned char* Y = (const unsigned char*)(F.ws + WS_Y);
    const float* modf = (const float*)(F.ws + WS_MODF); const float* nf = a.in[31];
    const int gw = F.vcu * NWAVES + F.wave, NGW = F.G * NWAVES; const int lane = F.lane, c0 = 16 * lane;
    for (int tok = gw; tok < M; tok += NGW) {
        const int b = tok >> 13;
        float acc[16];
        { const bf16* sp = (const bf16*)(F.ws + WS_SH) + (size_t)tok * D + c0; const v4u q0 = *(const GAS v4u*)sp, q1 = *(const GAS v4u*)(sp + 8);
          acc[0] = bflo(q0.x); acc[1] = bfhi(q0.x); acc[2] = bflo(q0.y); acc[3] = bfhi(q0.y); acc[4] = bflo(q0.z); acc[5] = bfhi(q0.z); acc[6] = bflo(q0.w); acc[7] = bfhi(q0.w);
          acc[8] = bflo(q1.x); acc[9] = bfhi(q1.x); acc[10] = bflo(q1.y); acc[11] = bfhi(q1.y); acc[12] = bflo(q1.z); acc[13] = bfhi(q1.z); acc[14] = bflo(q1.w); acc[15] = bfhi(q1.w); }
        v4u yq[8]; float wk[8];
#pragma unroll
        for (int k = 0; k < 8; ++k) { const int sl = slot[(size_t)tok * 8 + k]; wk[k] = wt[(size_t)tok * 8 + k] * 0.125f;
            const int crow = ecs[sl >> 16] + (sl & 0xffff); yq[k] = *(const GAS v4u*)(Y + (size_t)crow * 1024 + c0); }
#pragma unroll
        for (int k = 0; k < 8; ++k) { const unsigned wd[4] = {yq[k].x, yq[k].y, yq[k].z, yq[k].w};
#pragma unroll
            for (int j = 0; j < 4; ++j) { acc[4 * j + 0] += wk[k] * __builtin_amdgcn_cvt_f32_fp8((int)wd[j], 0); acc[4 * j + 1] += wk[k] * __builtin_amdgcn_cvt_f32_fp8((int)wd[j], 1);
                acc[4 * j + 2] += wk[k] * __builtin_amdgcn_cvt_f32_fp8((int)wd[j], 2); acc[4 * j + 3] += wk[k] * __builtin_amdgcn_cvt_f32_fp8((int)wd[j], 3); } }
        float* xr = F.out + (size_t)tok * D + c0; const float* g2 = modf + b * 6144 + 5120 + c0; f32x4 xv[4]; float s = 0.f;
#pragma unroll
        for (int j = 0; j < 4; ++j) { const f32x4 x = *(const GAS f32x4*)(xr + 4 * j), g = *(const GAS f32x4*)(g2 + 4 * j);
            xv[j] = x + g * (f32x4){acc[4 * j], acc[4 * j + 1], acc[4 * j + 2], acc[4 * j + 3]}; s += (xv[j].x * xv[j].x + xv[j].y * xv[j].y) + (xv[j].z * xv[j].z + xv[j].w * xv[j].w); }
        const float rstd = 1.f / sqrtf(wave_sum(s) * (1.f / D) + RMS_EPS);
#pragma unroll
        for (int j = 0; j < 4; ++j) *(GAS f32x4*)(xr + 4 * j) = xv[j] * rstd * *(const GAS f32x4*)(nf + c0 + 4 * j);
    }
}


constexpr int RS = 72;
constexpr int NJOBS = 16 * 128;
typedef unsigned short us8 __attribute__((ext_vector_type(8)));
typedef _Float16 h8 __attribute__((ext_vector_type(8)));

__device__ __forceinline__ f32x4 mm16(const LAS bf16* pa, int sa, const LAS bf16* pb, int sb, f32x4 acc, int fr, int fq) {
#pragma unroll
    for (int ks = 0; ks < 2; ++ks) { const bf16x8 a = *(const LAS bf16x8*)(pa + fr * sa + 32 * ks + 8 * fq); const bf16x8 b = *(const LAS bf16x8*)(pb + fr * sb + 32 * ks + 8 * fq);
        acc = __builtin_amdgcn_mfma_f32_16x16x32_bf16(a, b, acc, 0, 0, 0); }
    return acc;
}
__device__ __forceinline__ f32x4 mm16g(const bf16* pa, int sa, const LAS bf16* pb, int sb, f32x4 acc, int fr, int fq) {
#pragma unroll
    for (int ks = 0; ks < 2; ++ks) { const bf16x8 a = *(const GAS bf16x8*)(pa + fr * sa + 32 * ks + 8 * fq); const bf16x8 b = *(const LAS bf16x8*)(pb + fr * sb + 32 * ks + 8 * fq);
        acc = __builtin_amdgcn_mfma_f32_16x16x32_bf16(a, b, acc, 0, 0, 0); }
    return acc;
}
__device__ __forceinline__ void unpack8(const v4u q, float (&o)[8]) { o[0] = bflo(q.x); o[1] = bfhi(q.x); o[2] = bflo(q.y); o[3] = bfhi(q.y); o[4] = bflo(q.z); o[5] = bfhi(q.z); o[6] = bflo(q.w); o[7] = bfhi(q.w); }
__device__ __forceinline__ v4u pack8(const float (&v)[8]) { v4u w; w.x = pk2(v[0], v[1]); w.y = pk2(v[2], v[3]); w.z = pk2(v[4], v[5]); w.w = pk2(v[6], v[7]); return w; }

__device__ __forceinline__ void p3_lin(Frame& F, const Args& a, int pm) {
    const bf16* proj = (const bf16*)(F.ws + WS_PROJ); bf16* Lin = (bf16*)(F.ws + WS_LIN); const float* mu = a.in[6];
    const int c0 = (F.tid & 31) * 8, r0 = F.tid >> 5;
    float muv[8];
#pragma unroll
    for (int j = 0; j < 8; ++j) muv[j] = mu[1536 + c0 + j];
#pragma unroll 1
    for (int half = 0; half < 4; ++half) { v4u pc[4], pq[4];
#pragma unroll
        for (int i = 0; i < 4; ++i) { const int m = pm * 256 + r0 + 16 * (4 * half + i); pc[i] = *(const GAS v4u*)(proj + (size_t)m * DIN + 1536 + c0);
            pq[i] = ((m & (SEQ - 1)) != 0) ? *(const GAS v4u*)(proj + (size_t)(m - 1) * DIN + 1536 + c0) : (v4u){0u, 0u, 0u, 0u}; }
#pragma unroll
        for (int i = 0; i < 4; ++i) { const int m = pm * 256 + r0 + 16 * (4 * half + i); float p[8], pp[8], o[8]; unpack8(pc[i], p); unpack8(pq[i], pp);
#pragma unroll
            for (int j = 0; j < 8; ++j) { const float sx = p[j] + (pp[j] - p[j]) * muv[j]; o[j] = c0 < 64 ? (2.f * fsig(2.f * sx) - 1.f) : (c0 < 128 ? sx : fsig(sx)); }
            *(GAS v4u*)(Lin + (size_t)m * 256 + c0) = pack8(o); } }
}


constexpr int L5_AT = 0, L5_BT = 9216, L5_KT = 18432, L5_RT = 27648, L5_BHT = 36864, L5_KHT = 46080, L5_VT = 55296, L5_AABF = 64512, L5_AAK = 80896, L5_RHS = 90112, L5_PS = 122880, L5_PB = 124928, L5_GL = 126976;
constexpr int L5_AHT = L5_BT, L5_UHT = L5_KT;
constexpr int L5_AABB = L5_RHS, L5_WD = L5_RHS + 9216, L5_TMP = L5_RHS + 9216 + 4096;
__device__ __forceinline__ float dpp_scan_add(float x) {
    int v;
    v = __builtin_amdgcn_update_dpp(0, __builtin_bit_cast(int, x), 0x111, 0xf, 0xf, true); x += __builtin_bit_cast(float, v);
    v = __builtin_amdgcn_update_dpp(0, __builtin_bit_cast(int, x), 0x112, 0xf, 0xf, true); x += __builtin_bit_cast(float, v);
    v = __builtin_amdgcn_update_dpp(0, __builtin_bit_cast(int, x), 0x114, 0xf, 0xf, true); x += __builtin_bit_cast(float, v);
    v = __builtin_amdgcn_update_dpp(0, __builtin_bit_cast(int, x), 0x118, 0xf, 0xf, true); x += __builtin_bit_cast(float, v);
    v = __builtin_amdgcn_update_dpp(0, __builtin_bit_cast(int, x), 0x142, 0xa, 0xf, false); x += __builtin_bit_cast(float, v);
    v = __builtin_amdgcn_update_dpp(0, __builtin_bit_cast(int, x), 0x143, 0xc, 0xf, false); x += __builtin_bit_cast(float, v);
    return x;
}
__device__ __forceinline__ unsigned dpp_wave_shr1(unsigned x, unsigned first) { return (unsigned)__builtin_amdgcn_update_dpp((int)first, (int)x, 0x138, 0xf, 0xf, false); }
struct P5In { v4u pr, pk, pv, lr, qr, qk, qv; h8 lw; };
__device__ __forceinline__ void p5_load(Frame& F, P5In& in, int jid) {
    const int chain = jid >> 7, c = jid & 127, b = chain >> 3, h = chain & 7, m = b * SEQ + c * 64 + F.lane, ch0 = 8 * F.wave;
    const bf16* pr = (const bf16*)(F.ws + WS_PROJ) + (size_t)m * DIN + h * 64 + ch0;
    in.pr = *(const GAS v4u*)(pr); in.pk = *(const GAS v4u*)(pr + 512); in.pv = *(const GAS v4u*)(pr + 1024);
    in.lw = *(const GAS h8*)((const _Float16*)(F.ws + WS_LW) + (size_t)m * 512 + h * 64 + ch0); in.lr = *(const GAS v4u*)((const bf16*)(F.ws + WS_AB) + (size_t)m * 512 + h * 64 + ch0);
    in.qr = (v4u){0u, 0u, 0u, 0u}; in.qk = in.qr; in.qv = in.qr;
    if (F.lane == 0 && c != 0) { in.qr = *(const GAS v4u*)(pr - DIN); in.qk = *(const GAS v4u*)(pr - DIN + 512); in.qv = *(const GAS v4u*)(pr - DIN + 1024); }
}
__device__ __forceinline__ v4u shfl_up1(const v4u x, const v4u first, int lane) {
    (void)lane; v4u r; r.x = dpp_wave_shr1(x.x, first.x); r.y = dpp_wave_shr1(x.y, first.y); r.z = dpp_wave_shr1(x.z, first.z); r.w = dpp_wave_shr1(x.w, first.w); return r;
}
__device__ __forceinline__ void p5_job(Frame& F, const Args& a, int jid, const P5In& in) {
    const int chain = jid >> 7, c = jid & 127, b = chain >> 3, h = chain & 7, m0 = b * SEQ + c * 64;
    bf16* AH = (bf16*)(F.ws + WS_AH) + (size_t)jid * 4096; bf16* UH = (bf16*)(F.ws + WS_UH) + (size_t)jid * 4096; bf16* PM = (bf16*)(F.ws + WS_PM) + (size_t)jid * 4096;
    float* QT = (float*)(F.ws + WS_QM) + (size_t)jid * 4096;
    bf16* RTg = (bf16*)F.out + (size_t)jid * 4096; bf16* ARB = (bf16*)F.out + (size_t)(NJOBS + jid) * 4096; bf16* ARK = (bf16*)F.out + (size_t)(2 * NJOBS + jid) * 4096; bf16* VTg = (bf16*)F.out + (size_t)(3 * NJOBS + jid) * 4096;
    float* bonus = (float*)(F.ws + WS_BONUS);
    const float* mu = a.in[6]; const float* k_k = a.in[12]; const float* k_a = a.in[13]; const float* r_k = a.in[14];
    LAS bf16* at = (LAS bf16*)(F.lds + L5_AT); LAS bf16* bt = (LAS bf16*)(F.lds + L5_BT); LAS bf16* kt = (LAS bf16*)(F.lds + L5_KT); LAS bf16* rt = (LAS bf16*)(F.lds + L5_RT);
    LAS bf16* bhT = (LAS bf16*)(F.lds + L5_BHT); LAS bf16* khT = (LAS bf16*)(F.lds + L5_KHT); LAS bf16* VT = (LAS bf16*)(F.lds + L5_VT);
    LAS float* Aabf = (LAS float*)(F.lds + L5_AABF); LAS bf16* Aak = (LAS bf16*)(F.lds + L5_AAK);
    LAS float* psum = (LAS float*)(F.lds + L5_PS); LAS float* pbon = (LAS float*)(F.lds + L5_PB); LAS float* GLs = (LAS float*)(F.lds + L5_GL);
    LAS bf16* AhT = (LAS bf16*)(F.lds + L5_AHT); LAS bf16* UhT = (LAS bf16*)(F.lds + L5_UHT);
    LAS bf16* AabB = (LAS bf16*)(F.lds + L5_AABB); LAS bf16* Wd = (LAS bf16*)(F.lds + L5_WD);
    int w_ = F.wave, lane_ = F.lane; asm volatile("" : "+s"(w_)); asm volatile("" : "+v"(lane_));
    const int w = w_, lane = lane_, t = lane, ch0 = 8 * w, fr = lane & 15, fq = lane >> 4;
    LAS bf16* tmpw = (LAS bf16*)(F.lds + L5_TMP) + w * 512;
    float r[8], k[8], v[8], lw[8], lr[8], kkr[8], kmod[8], G[8], GL[8];
    {
        float pr_[8], pk_[8], pv_[8], qr_[8], qk_[8], qv_[8];
        unpack8(in.pr, pr_); unpack8(in.pk, pk_); unpack8(in.pv, pv_);
        unpack8(shfl_up1(in.pr, in.qr, lane), qr_); unpack8(shfl_up1(in.pk, in.qk, lane), qk_); unpack8(shfl_up1(in.pv, in.qv, lane), qv_);
        const h8 lwh = in.lw; unpack8(in.lr, lr);
        float ssq = 0.f, bon = 0.f;
#pragma unroll
        for (int j = 0; j < 8; ++j) { const int cc = h * 64 + ch0 + j;
            r[j] = pr_[j] + (qr_[j] - pr_[j]) * mu[cc]; k[j] = pk_[j] + (qk_[j] - pk_[j]) * mu[512 + cc]; v[j] = pv_[j] + (qv_[j] - pv_[j]) * mu[1024 + cc];
            lw[j] = (float)lwh[j]; kkr[j] = k[j] * k_k[cc]; ssq += kkr[j] * kkr[j]; kmod[j] = k[j] * (1.f + (lr[j] - 1.f) * k_a[cc]); bon += r[j] * kmod[j] * r_k[cc]; G[j] = lw[j]; }
        psum[w * 64 + t] = ssq; pbon[w * 64 + t] = bon;
#pragma unroll
        for (int j = 0; j < 8; ++j) { G[j] = dpp_scan_add(G[j]); GL[j] = __builtin_bit_cast(float, __builtin_amdgcn_readlane(__builtin_bit_cast(int, G[j]), 63)); }
        if (lane == 63) {
#pragma unroll
            for (int j = 0; j < 8; ++j) GLs[ch0 + j] = G[j]; }
    }
    LBAR();
    {
        float ssq = 0.f;
#pragma unroll
        for (int q = 0; q < 8; ++q) ssq += psum[q * 64 + t];
        const float invn = 1.f / fmaxf(sqrtf(ssq), 1e-12f);
        if (w == 0) { float bon = 0.f;
#pragma unroll
            for (int q = 0; q < 8; ++q) bon += pbon[q * 64 + t];
            bonus[(size_t)jid * 64 + t] = bon; }
        float o_at[8], o_bt[8], o_kt[8], o_rt[8], o_bh[8], o_kh[8];
#pragma unroll
        for (int j = 0; j < 8; ++j) { const float kkn = kkr[j] * invn, bb = kkn * lr[j];
            const float eG = __expf(G[j]), eGm = __expf(G[j] - lw[j]), enG = __expf(-G[j]), eGL = __expf(GL[j] - G[j]);
            o_at[j] = -kkn * eGm; o_bt[j] = bb * enG; o_kt[j] = kmod[j] * enG; o_rt[j] = r[j] * eG; o_bh[j] = bb * eGL; o_kh[j] = kmod[j] * eGL; }
        *(LAS v4u*)(at + t * RS + ch0) = pack8(o_at); *(LAS v4u*)(bt + t * RS + ch0) = pack8(o_bt); *(LAS v4u*)(kt + t * RS + ch0) = pack8(o_kt);
        const v4u rtp = pack8(o_rt); *(LAS v4u*)(rt + t * RS + ch0) = rtp; *(GAS v4u*)(RTg + t * 64 + ch0) = rtp;
#pragma unroll
        for (int j = 0; j < 8; ++j) { bhT[(ch0 + j) * RS + t] = (bf16)f2bf(o_bh[j]); khT[(ch0 + j) * RS + t] = (bf16)f2bf(o_kh[j]); const bf16 vb = (bf16)f2bf(v[j]); VT[(ch0 + j) * RS + t] = vb; VTg[(ch0 + j) * 64 + t] = vb; }
    }
    LBAR();
    {
        const int q = w >> 1; const LAS bf16* pa = (q < 2) ? at : rt; const LAS bf16* pb = (q & 1) ? kt : bt;
#pragma unroll
        for (int i2 = 0; i2 < 2; ++i2) { const int i = 2 * (w & 1) + i2, tt = 16 * i + fr;
#pragma unroll
            for (int ni = 0; ni < 4; ++ni) { f32x4 acc = (f32x4){0.f, 0.f, 0.f, 0.f};
                if (ni <= i) acc = mm16(pb + 16 * ni * RS, RS, pa + 16 * i * RS, RS, acc, fr, fq);
                const int s0 = 16 * ni + 4 * fq; float vv[4];
#pragma unroll
                for (int reg = 0; reg < 4; ++reg) { const int sx = s0 + reg; const bool keep = (q < 2) ? (sx < tt) : (sx <= tt); vv[reg] = keep ? acc[reg] : 0.f; }
                v2u pk; pk.x = pk2(vv[0], vv[1]); pk.y = pk2(vv[2], vv[3]);
                if (q == 0) {
#pragma unroll
                    for (int reg = 0; reg < 4; ++reg) Aabf[(s0 + reg) * 64 + tt] = vv[reg];
                    *(LAS v2u*)(AabB + tt * RS + s0) = pk; }
                else if (q == 1) *(LAS v2u*)(Aak + tt * RS + s0) = pk;
                else if (q == 2) *(GAS v2u*)(ARB + tt * 64 + s0) = pk;
                else *(GAS v2u*)(ARK + tt * 64 + s0) = pk; } }
    }
    LBAR();
    {
        { const int bi = lane >> 4, cc = lane & 15; float acc[16];
#pragma unroll
          for (int r = 0; r < 16; ++r) acc[r] = (r == cc) ? 1.f : 0.f;
#pragma unroll
          for (int sp = 0; sp < 15; ++sp) {
#pragma unroll
              for (int r4 = 0; r4 < 4; ++r4) { if (4 * r4 + 3 > sp) { const f32x4 av = *(const LAS f32x4*)(Aabf + (16 * bi + sp) * 64 + 16 * bi + 4 * r4);
                  if (4 * r4 + 0 > sp) acc[4 * r4 + 0] += av.x * acc[sp]; if (4 * r4 + 1 > sp) acc[4 * r4 + 1] += av.y * acc[sp]; if (4 * r4 + 2 > sp) acc[4 * r4 + 2] += av.z * acc[sp]; if (4 * r4 + 3 > sp) acc[4 * r4 + 3] += av.w * acc[sp]; } } }
#pragma unroll
          for (int r = 0; r < 16; ++r) { Wd[(bi * 16 + r) * 32 + cc] = (bf16)f2bf(acc[r]); Wd[(bi * 16 + r) * 32 + 16 + cc] = 0; } }
        LAS bf16* XT = (w < 4) ? (AhT + 16 * w * RS) : (UhT + 16 * (w - 4) * RS);
#pragma unroll
        for (int i = 0; i < 2; ++i) { const int e = lane + 64 * i; *(LAS v4u*)(XT + (e >> 3) * RS + (e & 7) * 8) = (v4u){0u, 0u, 0u, 0u}; }
        *(LAS v4u*)(tmpw + fr * 32 + 16 + 8 * (fq & 1)) = (v4u){0u, 0u, 0u, 0u};
        LDS_WAIT();
#pragma unroll
        for (int i = 0; i < 4; ++i) {
            f32x4 acc;
            if (w < 4) {
#pragma unroll
                for (int reg = 0; reg < 4; ++reg) acc[reg] = bf2f(at[(16 * i + 4 * fq + reg) * RS + 16 * w + fr]);
            } else acc = mm16(Aak + 16 * i * RS, RS, VT + 16 * (w - 4) * RS, RS, (f32x4){0.f, 0.f, 0.f, 0.f}, fr, fq);
            if (i > 0) acc = mm16(AabB + 16 * i * RS, RS, XT, RS, acc, fr, fq);
            { v2u pk; pk.x = pk2(acc[0], acc[1]); pk.y = pk2(acc[2], acc[3]); *(LAS v2u*)(tmpw + fr * 32 + 4 * fq) = pk; }
            LDS_WAIT();
            const bf16x8 wa = *(const LAS bf16x8*)(Wd + (i * 16 + fr) * 32 + 8 * fq); const bf16x8 tb = *(const LAS bf16x8*)(tmpw + fr * 32 + 8 * fq);
            const f32x4 x = __builtin_amdgcn_mfma_f32_16x16x32_bf16(wa, tb, (f32x4){0.f, 0.f, 0.f, 0.f}, 0, 0, 0);
            v2u xp; xp.x = pk2(x[0], x[1]); xp.y = pk2(x[2], x[3]);
            *(LAS v2u*)(XT + fr * RS + 16 * i + 4 * fq) = xp;
            if (w < 4) {
#pragma unroll
                for (int reg = 0; reg < 4; ++reg) AH[(16 * i + 4 * fq + reg) * 64 + 16 * w + fr] = (bf16)(reg & 1 ? ((reg & 2 ? xp.y : xp.x) >> 16) : ((reg & 2 ? xp.y : xp.x) & 0xffffu));
            } else *(GAS v2u*)(UH + (16 * (w - 4) + fr) * 64 + 16 * i + 4 * fq) = xp;
            LDS_WAIT();
        }
    }
    LBAR();
    if (w < 4) {
#pragma unroll
        for (int ni = 0; ni < 4; ++ni) { f32x4 acc = mm16(bhT + 16 * w * RS, RS, AhT + 16 * ni * RS, RS, (f32x4){0.f, 0.f, 0.f, 0.f}, fr, fq);
#pragma unroll
            for (int reg = 0; reg < 4; ++reg) { const int j = 16 * w + 4 * fq + reg, jp = 16 * ni + fr; float val = acc[reg]; if (j == jp) val += __expf(GLs[j]);
                PM[(((((j >> 4) * 2 + (jp >> 5)) * 4 + ((jp & 31) >> 3)) * 16 + (j & 15)) << 3) + (jp & 7)] = (bf16)f2bf(val); } }
    } else { const int i = w - 4;
#pragma unroll
        for (int ni = 0; ni < 4; ++ni) { f32x4 acc = mm16(bhT + 16 * i * RS, RS, UhT + 16 * ni * RS, RS, (f32x4){0.f, 0.f, 0.f, 0.f}, fr, fq);
            acc = mm16(khT + 16 * i * RS, RS, VT + 16 * ni * RS, RS, acc, fr, fq);
            { v2u qp; qp.x = pk2(acc[0], acc[1]); qp.y = pk2(acc[2], acc[3]); *(GAS v2u*)((bf16*)QT + (((ni * 4 + i) * 4 + fq) * 16 + fr) * 4) = qp; } } }
    LBAR();
}

constexpr int P6_SLOT = 10240, P6_NSLOT = 12, P6_AHEAD = 11, P6_HT = P6_SLOT * P6_NSLOT, P6_HTE = 16 * RS;
static_assert(P6_HT + 2 * P6_HTE * 2 <= RING_BYTES, "P6 LDS map");
template <int NP> __device__ __forceinline__ void p6_loader(Frame& F, const bf16* PMc, const bf16* QTc, int p0, int lane) {
#define P6_ISSUE(c_) do { const int _c = (c_); LAS unsigned char* _slot = F.lds + (_c % P6_NSLOT) * P6_SLOT; \
        _Pragma("unroll") for (int _i = 0; _i < NP; ++_i) { const int _p = p0 + _i; \
            const char* _src = (_p < 8) ? ((const char*)(PMc + (size_t)_c * 4096) + _p * 1024) : ((const char*)(QTc + (size_t)_c * 8192) + (_p - 8) * 1024); \
            __builtin_amdgcn_global_load_lds((const unsigned*)(_src + lane * 16), (LAS unsigned*)(_slot + _p * 1024), 16, 0, 0); } } while (0)
#define P6_WAIT10() do { if constexpr (NP == 3) asm volatile("s_waitcnt vmcnt(30)" ::: "memory"); else asm volatile("s_waitcnt vmcnt(20)" ::: "memory"); } while (0)
#pragma unroll 1
    for (int c = 0; c < P6_AHEAD; ++c) P6_ISSUE(c);
    P6_WAIT10();
    __builtin_amdgcn_s_barrier();
#pragma unroll 1
    for (int c = 0; c < 128; ++c) {
        if (c + P6_AHEAD < 128) { P6_ISSUE(c + P6_AHEAD); P6_WAIT10(); }
        else asm volatile("s_waitcnt vmcnt(0)" ::: "memory");
        __builtin_amdgcn_s_barrier();
    }
#undef P6_ISSUE
#undef P6_WAIT10
}
__device__ __forceinline__ void p6_scan(Frame& F, int chain, int vt) {
    const int w = F.wave, lane = F.lane, fr = lane & 15, fq = lane >> 4;
    const bf16* PMc = (const bf16*)(F.ws + WS_PM) + (size_t)chain * 128 * 4096; const bf16* QTc = (const bf16*)(F.ws + WS_QM) + (size_t)chain * 128 * 8192 + vt * 1024;
    if (w >= 4) {
        if (w < 6) p6_loader<3>(F, PMc, QTc, 3 * (w - 4), lane); else p6_loader<2>(F, PMc, QTc, 2 * (w - 6) + 6, lane);
        return;
    }
    const int mi = w;
    LAS bf16* HT = (LAS bf16*)(F.lds + P6_HT);
    bf16* H0c = (bf16*)(F.ws + WS_H0) + (size_t)chain * 128 * 4096;
    const int hoff = fr * RS + 16 * mi + 4 * fq;
    const int goff = (16 * vt + fr) * 64 + 16 * mi + 4 * fq;
    { const v2u z = (v2u){0u, 0u}; *(LAS v2u*)(HT + hoff) = z; *(GAS v2u*)(H0c + goff) = z; }
    asm volatile("s_waitcnt lgkmcnt(0)" ::: "memory");
    __builtin_amdgcn_s_barrier();
#pragma unroll 1
    for (int c = 0; c < 128; ++c) {
        const LAS unsigned char* slot = F.lds + (c % P6_NSLOT) * P6_SLOT;
        const LAS bf16* HTr = HT + (c & 1) * P6_HTE; LAS bf16* HTw = HT + ((c + 1) & 1) * P6_HTE;
        bf16x8 pa[2], hb[2];
        const v2u qb = *(const LAS v2u*)(slot + 8192 + ((mi * 4 + fq) * 16 + fr) * 8);
#pragma unroll
        for (int ks = 0; ks < 2; ++ks) { pa[ks] = *(const LAS bf16x8*)(slot + (((mi * 2 + ks) * 4 + fq) * 16 + fr) * 16); hb[ks] = *(const LAS bf16x8*)(HTr + fr * RS + 32 * ks + 8 * fq); }
        f32x4 acc = (f32x4){bflo(qb.x), bfhi(qb.x), bflo(qb.y), bfhi(qb.y)};
#pragma unroll
        for (int ks = 0; ks < 2; ++ks) acc = __builtin_amdgcn_mfma_f32_16x16x32_bf16(pa[ks], hb[ks], acc, 0, 0, 0);
        v2u pk; pk.x = pk2(acc[0], acc[1]); pk.y = pk2(acc[2], acc[3]);
        *(LAS v2u*)(HTw + hoff) = pk;
        if (c + 1 < 128) *(GAS v2u*)(H0c + (size_t)(c + 1) * 4096 + goff) = pk;
        asm volatile("s_waitcnt lgkmcnt(0)" ::: "memory");
        __builtin_amdgcn_s_barrier();
    }
}

__device__ __forceinline__ void p7_pair(Frame& F, const Args& a, int pair) {
    int w_ = F.wave, lane_ = F.lane; asm volatile("" : "+s"(w_)); asm volatile("" : "+v"(lane_));
    const int w = w_, lane = lane_, fr = lane & 15, fq = lane >> 4, w4 = w & 3, js = w >> 2, jid = 2 * pair + js;
    const int chain = jid >> 7, c = jid & 127, b = chain >> 3, h = chain & 7, m0 = b * SEQ + c * 64;
    const bf16* AH = (const bf16*)(F.ws + WS_AH) + (size_t)jid * 4096; const bf16* UH = (const bf16*)(F.ws + WS_UH) + (size_t)jid * 4096; const bf16* H0 = (const bf16*)(F.ws + WS_H0) + (size_t)jid * 4096;
    const bf16* RTg = (const bf16*)F.out + (size_t)jid * 4096; const bf16* ARB = (const bf16*)F.out + (size_t)(NJOBS + jid) * 4096; const bf16* ARK = (const bf16*)F.out + (size_t)(2 * NJOBS + jid) * 4096; const bf16* VTg = (const bf16*)F.out + (size_t)(3 * NJOBS + jid) * 4096;
    const float* bonus = (const float*)(F.ws + WS_BONUS); const bf16* Gb = (const bf16*)(F.ws + WS_GB); bf16* Ycat = (bf16*)(F.ws + WS_YCAT);
    const float* lng = a.in[15]; const float* lnb = a.in[16];
    LAS bf16* H0T = (LAS bf16*)(F.lds + js * 27648); LAS bf16* VT = H0T + 64 * RS; LAS bf16* UT = VT + 64 * RS;
    const int tl = w4 * 64 + lane; v4u sh0[2], sv0[2];
#pragma unroll
    for (int i = 0; i < 2; ++i) { const int e = tl + 256 * i, row = e >> 3, c8 = (e & 7) * 8; sh0[i] = *(const GAS v4u*)(H0 + row * 64 + c8); sv0[i] = *(const GAS v4u*)(VTg + row * 64 + c8); }
    v2u uh[4];
#pragma unroll
    for (int ni = 0; ni < 4; ++ni) uh[ni] = *(const GAS v2u*)(UH + (16 * ni + fr) * 64 + 16 * w4 + 4 * fq);
    bf16x8 fa[4][2];
#pragma unroll
    for (int ks = 0; ks < 2; ++ks) { const int o = (16 * w4 + fr) * 64 + 32 * ks + 8 * fq;
        fa[0][ks] = *(const GAS bf16x8*)(AH + o); fa[1][ks] = *(const GAS bf16x8*)(RTg + o); fa[2][ks] = *(const GAS bf16x8*)(ARB + o); fa[3][ks] = *(const GAS bf16x8*)(ARK + o); }
    unsigned short gq[4][4]; float bon4[4];
#pragma unroll
    for (int reg = 0; reg < 4; ++reg) { const int tt = 16 * w4 + 4 * fq + reg; bon4[reg] = bonus[(size_t)jid * 64 + tt];
#pragma unroll
        for (int ni = 0; ni < 4; ++ni) gq[reg][ni] = Gb[(size_t)(m0 + tt) * 512 + h * 64 + 16 * ni + fr]; }
#pragma unroll
    for (int i = 0; i < 2; ++i) { const int e = tl + 256 * i, row = e >> 3, c8 = (e & 7) * 8; *(LAS v4u*)(H0T + row * RS + c8) = sh0[i]; *(LAS v4u*)(VT + row * RS + c8) = sv0[i]; }
    LBAR();
#pragma unroll
    for (int ni = 0; ni < 4; ++ni) { f32x4 acc = (f32x4){bflo(uh[ni].x), bfhi(uh[ni].x), bflo(uh[ni].y), bfhi(uh[ni].y)};
#pragma unroll
        for (int ks = 0; ks < 2; ++ks) acc = __builtin_amdgcn_mfma_f32_16x16x32_bf16(fa[0][ks], *(const LAS bf16x8*)(H0T + (16 * ni + fr) * RS + 32 * ks + 8 * fq), acc, 0, 0, 0);
        v2u pk; pk.x = pk2(acc[0], acc[1]); pk.y = pk2(acc[2], acc[3]); *(LAS v2u*)(UT + (16 * ni + fr) * RS + 16 * w4 + 4 * fq) = pk; }
    LBAR();
    f32x4 o[4];
#pragma unroll
    for (int ni = 0; ni < 4; ++ni) { f32x4 acc = (f32x4){0.f, 0.f, 0.f, 0.f};
#pragma unroll
        for (int ks = 0; ks < 2; ++ks) { const int bo = (16 * ni + fr) * RS + 32 * ks + 8 * fq;
            acc = __builtin_amdgcn_mfma_f32_16x16x32_bf16(fa[1][ks], *(const LAS bf16x8*)(H0T + bo), acc, 0, 0, 0);
            acc = __builtin_amdgcn_mfma_f32_16x16x32_bf16(fa[2][ks], *(const LAS bf16x8*)(UT + bo), acc, 0, 0, 0);
            acc = __builtin_amdgcn_mfma_f32_16x16x32_bf16(fa[3][ks], *(const LAS bf16x8*)(VT + bo), acc, 0, 0, 0); }
        o[ni] = acc; }
#pragma unroll
    for (int reg = 0; reg < 4; ++reg) { const int tt = 16 * w4 + 4 * fq + reg, m = m0 + tt;
        float s = (o[0][reg] + o[1][reg]) + (o[2][reg] + o[3][reg]);
#pragma unroll
        for (int x = 1; x < 16; x <<= 1) s += __shfl_xor(s, x);
        const float mean = s * (1.f / 64.f); float q = 0.f;
#pragma unroll
        for (int ni = 0; ni < 4; ++ni) { const float d = o[ni][reg] - mean; q += d * d; }
#pragma unroll
        for (int x = 1; x < 16; x <<= 1) q += __shfl_xor(q, x);
        const float rstd = 1.f / sqrtf(q * (1.f / 64.f) + 64e-5f); const float bon = bon4[reg];
#pragma unroll
        for (int ni = 0; ni < 4; ++ni) { const int vch = 16 * ni + fr, cc = h * 64 + vch;
            const float y = (o[ni][reg] - mean) * rstd * lng[cc] + lnb[cc] + bon * bf2f(VT[vch * RS + tt]);
            Ycat[(size_t)m * D + cc] = (bf16)f2bf(y * bf2f(gq[reg][ni])); } }
    LBAR();
}


__global__ void __launch_bounds__(NWAVES * 64, 2) mega_fwd(Args args) {
    extern __shared__ __attribute__((aligned(16))) unsigned char lds[];
    Frame F;
    F.lds = (LAS unsigned char*)lds;
    F.MISC = (volatile LAS unsigned*)(F.lds + MISC_OFF);
    F.tid = threadIdx.x; F.lane = F.tid & 63; F.wave = __builtin_amdgcn_readfirstlane(F.tid >> 6);
    F.G = gridDim.x; { const int bx = blockIdx.x; F.vcu = (F.G % 8 == 0) ? (bx % 8) * (F.G / 8) + bx / 8 : bx; }
    F.ws = args.ws; F.out = args.out;
    F.ctl = (gu32*)(F.ws + WS_CTL);
    for (int u = F.tid; u < (LDS_BYTES - LDSCTL_OFF) / 4; u += NWAVES * 64) ((LAS unsigned*)(F.lds + LDSCTL_OFF))[u] = 0u;
    __syncthreads();
    XcdBarrier bar = xcd_barrier_post((unsigned*)(F.ctl + CW_BAR) + args.li * XCD_BAR_WORDS, F.MISC + 8);
    const int lo = args.ph_lo, hi = args.ph_hi;
#define IN(k) (lo <= (k) && (k) < hi)
#define SEAM(k) do { if (IN(k) && IN((k) + 1)) xcd_barrier(bar); } while (0)
    const int gw = F.vcu * NWAVES + F.wave, NGW = F.G * NWAVES; (void)gw; (void)NGW;

    if (IN(0)) { p0_prologue(F, args); } SEAM(0);
    if (IN(1)) { p1_h(F, args); } SEAM(1);
    if (IN(2)) {
        pg8::Gemm g{(const pg8::bf16_t*)(F.ws + WS_HBUF), (const pg8::bf16_t*)(F.ws + WS_WIN), M, DIN, D}; pg8::StaticOrder S; S.init(M, DIN, F.G, (int)blockIdx.x);
        pg8::EpiBf16Plain E{(pg8::bf16_t*)(F.ws + WS_PROJ), DIN};
        pg8::gemm_phase<pg8::EpiBf16Plain, pg8::StaticOrder, true, true>(F.lds + RING_OFF, g, S, E);
    } SEAM(2);
    if (IN(4)) {
        { const int c = (int)blockIdx.x; int pm0 = 8 * (c & 7) + ((c >> 3) & 7);
          if (pm0 >= 0) { p3_lin(F, args, __builtin_amdgcn_readfirstlane(pm0)); VM_WAIT(); __syncthreads(); } }
        pg8::Gemm g{(const pg8::bf16_t*)(F.ws + WS_LIN), (const pg8::bf16_t*)(F.ws + WS_WLORA), M, 1536, 256}; pg8::StaticOrder S; S.init(M, 1536, F.G, (int)blockIdx.x);
        pg8::EpiLora E{(_Float16*)(F.ws + WS_LW), (pg8::bf16_t*)(F.ws + WS_AB), (pg8::bf16_t*)(F.ws + WS_GB), args.in[7], args.in[9]};
        pg8::gemm_phase<pg8::EpiLora, pg8::StaticOrder, true, true>(F.lds + RING_OFF, g, S, E);
    } SEAM(4);
    if (IN(5)) { { P5In cur, nxt; int j = (int)blockIdx.x; if (j < NJOBS) p5_load(F, cur, j);
          for (; j < NJOBS; j += F.G) { if (j + F.G < NJOBS) p5_load(F, nxt, j + F.G); p5_job(F, args, j, cur); cur = nxt; } } } SEAM(5);
    if (IN(6)) { if ((int)blockIdx.x < 64) { p6_scan(F, (int)blockIdx.x & 15, (int)blockIdx.x >> 4); __syncthreads();
        }
        for (;;) {
            if (F.tid == 0) F.MISC[16] = __hip_atomic_fetch_add((unsigned*)(F.ctl + CW_SGUQ), 1u, __ATOMIC_RELAXED, __HIP_MEMORY_SCOPE_AGENT);
            LDS_WAIT(); __syncthreads(); const int it = (int)F.MISC[16]; __syncthreads();
            if (it >= 512) break;
            sgu_item(F, args, it); } } SEAM(6);
    if (IN(7)) { for (int pr = (int)blockIdx.x; pr < NJOBS / 2; pr += F.G) p7_pair(F, args, pr); } SEAM(7);
    if (IN(8)) {
        pg8::Gemm g{(const pg8::bf16_t*)(F.ws + WS_YCAT), (const pg8::bf16_t*)(F.ws + WS_WOUT), M, D, D}; pg8::StaticOrder S; S.init(M, D, F.G, (int)blockIdx.x);
        pg8::EpiResGate E{args.in[0], F.out, (const float*)(F.ws + WS_MODF) + 2048, 6144};
        pg8::gemm_phase<pg8::EpiResGate, pg8::StaticOrder, true, true>(F.lds + RING_OFF, g, S, E);
        convert_w13(F, args);
    } SEAM(8);
    if (IN(9)) { p9_h2(F, args); } SEAM(9);
    if (IN(10)) {
        { pg8::Gemm g{(const pg8::bf16_t*)(F.ws + WS_H2), (const pg8::bf16_t*)(F.ws + WS_WS13), M, 768, D}; pg8::StaticOrder S; S.init(M, 768, F.G, (int)blockIdx.x);
          pg8::EpiSwiglu<true> E{(pg8::bf16_t*)(F.ws + WS_ACTS), (float*)(F.ws + WS_LOGIT), 3};
          pg8::gemm_phase<pg8::EpiSwiglu<true>, pg8::StaticOrder, true, true>(F.lds + RING_OFF, g, S, E); }
        { const int c = (int)blockIdx.x;
          if (F.G == 256 && (c >> 6) == 2) { VM_WAIT(); __syncthreads(); __builtin_amdgcn_fence(__ATOMIC_ACQUIRE, "agent"); VM_WAIT(); p11_route(F, args, (8 * (c & 7) + ((c >> 3) & 7)) * 4, 4); } }
        convert_w2_queue(F, args);
    } SEAM(10);
    if (IN(12)) {
        const int ntl = build_tile_table(F);
        { pg8::Gemm g{(const pg8::bf16_t*)(F.ws + WS_H2), (const pg8::bf16_t*)(F.ws + WS_WE13), M, 512, D};
          MoeOrder S{(const LAS int*)(F.lds + LX_TTAB), (const LAS int*)(F.lds + LX_ECNT), (const LAS int*)(F.lds + LX_ECNT) + 64, ntl * 2, 2, 0, 2, 1, F.G, F.vcu};
          pg8::EpiSwiglu<false> E{(pg8::bf16_t*)(F.ws + WS_ACT), nullptr, 2};
          pg8::gemm_phase_gather<pg8::EpiSwiglu<false>, MoeOrder, true>(F.lds + RING_OFF, g, S, E, (const int*)(F.ws + WS_ROWTOK), (LAS int*)(F.lds + LX_GTAB)); }
        { pg8::Gemm g{(const pg8::bf16_t*)(F.ws + WS_ACTS), (const pg8::bf16_t*)(F.ws + WS_WS2), M, D, 256};
          const int nun = ntl * 2, rounds = (nun + F.G - 1) / F.G, heavy = nun - (rounds - 1) * F.G;
          LightOrder S{heavy >= F.G ? F.vcu : (F.vcu >= heavy ? F.vcu - heavy : -1), heavy >= F.G ? F.G : F.G - heavy};
          pg8::EpiBf16Plain E{(pg8::bf16_t*)(F.ws + WS_SH), D};
          pg8::gemm_phase<pg8::EpiBf16Plain, LightOrder, true, true>(F.lds + RING_OFF, g, S, E); }
    } SEAM(12);
    if (IN(13)) {
        const int ntl = build_tile_table(F);
        pg8::Gemm g{(const pg8::bf16_t*)(F.ws + WS_ACT), (const pg8::bf16_t*)(F.ws + WS_WE2), ACT_ROWS, D, 256};
        MoeOrder S{(const LAS int*)(F.lds + LX_TTAB), (const LAS int*)(F.lds + LX_ECNT), (const LAS int*)(F.lds + LX_ECNT) + 64, ntl * 4, 4, 0, 4, 0, F.G, F.vcu};
        pg8::EpiDownY E{(unsigned char*)(F.ws + WS_Y)};
        pg8::gemm_phase<pg8::EpiDownY, MoeOrder, true, true>(F.lds + RING_OFF, g, S, E);
    } SEAM(13);
    if (IN(14)) { (void)build_tile_table(F); combine_all(F, args); }
#undef IN
#undef SEAM
}

extern "C" void kernel_launch(void* const* d_in, const int* in_sizes, int n_in, void* d_out, int out_size, void* d_ws, size_t ws_size, hipStream_t stream) {
    static int grid = 0;
    if (grid == 0) {
        if (n_in != 32 || in_sizes[0] != M * D || out_size != M * D || ws_size < WS_END) { fprintf(stderr, "kernel_launch: unexpected shapes (n_in %d, ws %zu); nothing launched\n", n_in, ws_size); grid = -1; return; }
        int dev = 0, cus = 0, per_cu = 0;
        if (hipGetDevice(&dev) != hipSuccess || hipDeviceGetAttribute(&cus, hipDeviceAttributeMultiprocessorCount, dev) != hipSuccess) { grid = -1; return; }
        if (hipFuncSetAttribute((const void*)mega_fwd, hipFuncAttributeMaxDynamicSharedMemorySize, LDS_BYTES) != hipSuccess) { fprintf(stderr, "kernel_launch: hipFuncSetAttribute failed\n"); grid = -1; return; }
        if (hipOccupancyMaxActiveBlocksPerMultiprocessor(&per_cu, (const void*)mega_fwd, NWAVES * 64, LDS_BYTES) != hipSuccess || per_cu < 1) { fprintf(stderr, "kernel_launch: occupancy query says %d blocks per CU\n", per_cu); }
        (void)hipGetLastError();
        grid = cus;
        if (cus != 256) { fprintf(stderr, "kernel_launch: built for a 256-CU device (the static unit ownership in the lora and router phases assumes 256 workgroups); found %d CUs, nothing launched\n", cus); grid = -1; return; }
    }
    if (grid < 0) return;
    (void)hipMemsetAsync((char*)d_ws + WS_CTL, 0, CTL_ZERO_BYTES, stream);
    Args a{};
    for (int i = 0; i < 32; ++i) a.in[i] = (const float*)d_in[i];
    a.out = (float*)d_out; a.ws = (unsigned char*)d_ws;
    a.ph_lo = 0; a.ph_hi = 15; a.li = 0;
    hipLaunchKernelGGL(mega_fwd, dim3(grid), dim3(NWAVES * 64), LDS_BYTES, stream, a);
}
```

```cpp
#include <hip/hip_runtime.h>
#include <cstdio>
#include <cstdint>

namespace pg8 {
#define PG8_LAS __attribute__((address_space(3)))
typedef unsigned short bf16_t;
typedef short bf16x8 __attribute__((ext_vector_type(8)));
typedef float f32x4 __attribute__((ext_vector_type(4)));
typedef unsigned u32x4 __attribute__((ext_vector_type(4)));
constexpr int BM = 256, BK = 64, HALF = 128, HTB = HALF * BK * 2  , STAGE_BYTES = 8 * HTB, NXCD = 8, WGM = 8;

__host__ __device__ __forceinline__ int lds_byte(int r, int c) { const int st = (r >> 4) * 2 + (c >> 5), rr = r & 15, cc = c & 31, ob = rr * 64 + cc * 2; return st * 1024 + (ob ^ (((ob >> 9) & 1) << 5)); }
__host__ __device__ __forceinline__ void stage_rc(int b, int& R, int& C) { const int st = b / 1024, sb = b % 1024, swz = sb ^ (((sb >> 9) & 1) << 5); R = (st >> 1) * 16 + swz / 64; C = (st & 1) * 32 + (swz % 64) / 2; }
__host__ __device__ __forceinline__ int perm32(int rho) { const int n = rho >> 4, i = rho & 15; return 8 * (i >> 2) + 4 * n + (i & 3); }

struct Unit { int pm, pn, a0, a1, a2; };
struct Gemm { const bf16_t* A; const bf16_t* Bt; int M, N, K; };

struct StaticOrder {
    static constexpr bool HAS_KO = false, TAILS = false; static constexpr int LD = 0;
    static __device__ __forceinline__ int koff(const Unit&) { return 0; }
    int nM, nN, nwg, G, c;
    __host__ __device__ void init(int M, int N, int G_, int c_) { nM = M / BM; nN = N / BM; nwg = nM * nN; G = G_; c = c_; }
    __host__ __device__ bool next(int i, Unit& u) const {
        const long L = (long)i * G + c; if (L >= nwg) return false;
        int wgid = (int)L; { const int q = nwg / NXCD, r = nwg % NXCD, xcd = wgid % NXCD, off = wgid / NXCD; wgid = (xcd < r ? xcd * (q + 1) : r * (q + 1) + (xcd - r) * q) + off; }
        const int nig = WGM * nN, gid = wgid / nig, fm = gid * WGM, gsz = (nM - fm) < WGM ? (nM - fm) : WGM;
        u.pm = fm + ((wgid % nig) % gsz); u.pn = (wgid % nig) / gsz; u.a0 = 0; u.a1 = 256; u.a2 = 0; return true;
    }
    __device__ __forceinline__ void a_ready(const Unit&) const {}
    __device__ __forceinline__ void done(const Unit&) const {}
};


typedef __bf16 bf16n2_t __attribute__((ext_vector_type(2)));
__device__ __forceinline__ unsigned cvt_pk_bf16(float lo, float hi) { bf16n2_t v; v.x = (__bf16)lo; v.y = (__bf16)hi; return __builtin_bit_cast(unsigned, v); }
__device__ __forceinline__ float fsigmoid(float x) { return __builtin_amdgcn_rcpf(1.0f + __expf(-x)); }
__device__ __forceinline__ float fsilu(float x) { return x * fsigmoid(x); }

struct EpiBf16Plain {
    static constexpr bool PERM = true, AFTER_DRAIN = false;
    bf16_t* O; int ldc;
    __device__ __forceinline__ void operator()(const f32x4 (&acc)[2][2][4][2], const Unit& u, int wr, int wc, int fr, int fq) const {
        const int row0 = u.pm * BM + wr * 64 + fr; const int col0 = u.pn * BM + wc * 32 + 8 * fq;
#pragma unroll
        for (int ai = 0; ai < 2; ++ai)
#pragma unroll
            for (int m = 0; m < 4; ++m) { bf16_t* rowp = O + (size_t)(row0 + ai * HALF + m * 16) * ldc + col0;
#pragma unroll
                for (int bj = 0; bj < 2; ++bj) { const f32x4 v0 = acc[ai][bj][m][0], v1 = acc[ai][bj][m][1];
                    u32x4 w; w.x = cvt_pk_bf16(v0[0], v0[1]); w.y = cvt_pk_bf16(v0[2], v0[3]); w.z = cvt_pk_bf16(v1[0], v1[1]); w.w = cvt_pk_bf16(v1[2], v1[3]);
                    *(u32x4*)(rowp + bj * HALF) = w; } }
    }
};

struct EpiLora {
    static constexpr bool PERM = true, AFTER_DRAIN = false;
    _Float16* LW; bf16_t* Ab; bf16_t* Gb; const float* w0; const float* a0;
    template <int KIND> __device__ __forceinline__ void body(const f32x4 (&acc)[2][2][4][2], const Unit& u, int wr, int wc, int fr, int fq) const {
        const int row0 = u.pm * BM + wr * 64 + fr; const int colt = (u.pn & 1) * BM + wc * 32 + 8 * fq;
        const float* cbp = KIND == 0 ? w0 : a0;
#pragma unroll
        for (int bj = 0; bj < 2; ++bj) { float cb[8];
#pragma unroll
            for (int i = 0; i < 8; ++i) cb[i] = KIND == 2 ? 0.f : cbp[colt + bj * HALF + i];
#pragma unroll
            for (int ai = 0; ai < 2; ++ai)
#pragma unroll
                for (int m = 0; m < 4; ++m) { const size_t ro = (size_t)(row0 + ai * HALF + m * 16) * 512 + colt + bj * HALF; float v[8];
#pragma unroll
                    for (int i = 0; i < 4; ++i) { v[i] = acc[ai][bj][m][0][i] + cb[i]; v[4 + i] = acc[ai][bj][m][1][i] + cb[4 + i]; }
                    if (KIND == 0) {
                        typedef _Float16 h8 __attribute__((ext_vector_type(8))); h8 o;
#pragma unroll
                        for (int i = 0; i < 8; ++i) o[i] = (_Float16)(-0.60653066f * fsigmoid(v[i]));
                        *(h8*)(LW + ro) = o;
                    } else {
                        if (KIND == 1) {
#pragma unroll
                            for (int i = 0; i < 8; ++i) v[i] = fsigmoid(v[i]); }
                        u32x4 w; w.x = cvt_pk_bf16(v[0], v[1]); w.y = cvt_pk_bf16(v[2], v[3]); w.z = cvt_pk_bf16(v[4], v[5]); w.w = cvt_pk_bf16(v[6], v[7]);
                        *(u32x4*)((KIND == 1 ? Ab : Gb) + ro) = w;
                    } } }
    }
    __device__ __forceinline__ void operator()(const f32x4 (&acc)[2][2][4][2], const Unit& u, int wr, int wc, int fr, int fq) const {
        const int kind = u.pn >> 1;
        if (kind == 0) body<0>(acc, u, wr, wc, fr, fq); else if (kind == 1) body<1>(acc, u, wr, wc, fr, fq); else body<2>(acc, u, wr, wc, fr, fq);
    }
};

struct EpiResGate {
    static constexpr bool PERM = true, AFTER_DRAIN = false;
    const float* base; bf16_t* out; const float* gate;
    int gstride;
    __device__ __forceinline__ void operator()(const f32x4 (&acc)[2][2][4][2], const Unit& u, int wr, int wc, int fr, int fq) const {
        const int row0 = u.pm * BM + wr * 64 + fr; const int col0 = u.pn * BM + wc * 32 + 8 * fq; const int b = (u.pm * BM) >> 13;
        f32x4 gv[2][2];
#pragma unroll
        for (int bj = 0; bj < 2; ++bj)
#pragma unroll
            for (int n = 0; n < 2; ++n) gv[bj][n] = *(const f32x4*)(gate + (size_t)b * gstride + col0 + bj * HALF + 4 * n);
#pragma unroll
        for (int ai = 0; ai < 2; ++ai)
#pragma unroll
            for (int m = 0; m < 4; ++m) { const size_t off = (size_t)(row0 + ai * HALF + m * 16) * 1024 + col0;
#pragma unroll
                for (int bj = 0; bj < 2; ++bj) { const f32x4 v0 = *(const f32x4*)(base + off + bj * HALF) + gv[bj][0] * acc[ai][bj][m][0], v1 = *(const f32x4*)(base + off + bj * HALF + 4) + gv[bj][1] * acc[ai][bj][m][1];
                    u32x4 w; w.x = cvt_pk_bf16(v0[0], v0[1]); w.y = cvt_pk_bf16(v0[2], v0[3]); w.z = cvt_pk_bf16(v1[0], v1[1]); w.w = cvt_pk_bf16(v1[2], v1[3]);
                    *(u32x4*)(out + off + bj * HALF) = w; } }
    }
};

struct EpiResAddBf16 {
    static constexpr bool PERM = true, AFTER_DRAIN = false;
    const bf16_t* x1; bf16_t* out; const float* gate; int gstride;
    __device__ __forceinline__ void operator()(const f32x4 (&acc)[2][2][4][2], const Unit& u, int wr, int wc, int fr, int fq) const {
        const int row0 = u.pm * BM + wr * 64 + fr; const int col0 = u.pn * BM + wc * 32 + 8 * fq; const int b = (u.pm * BM) >> 13;
        f32x4 gv[2][2];
#pragma unroll
        for (int bj = 0; bj < 2; ++bj)
#pragma unroll
            for (int n = 0; n < 2; ++n) gv[bj][n] = *(const f32x4*)(gate + (size_t)b * gstride + col0 + bj * HALF + 4 * n);
#pragma unroll
        for (int ai = 0; ai < 2; ++ai)
#pragma unroll
            for (int m = 0; m < 4; ++m) { const size_t off = (size_t)(row0 + ai * HALF + m * 16) * 1024 + col0;
#pragma unroll
                for (int bj = 0; bj < 2; ++bj) { const u32x4 q = *(const u32x4*)(x1 + off + bj * HALF);
                    const f32x4 x0 = (f32x4){__builtin_bit_cast(float, q.x << 16), __builtin_bit_cast(float, q.x & 0xffff0000u), __builtin_bit_cast(float, q.y << 16), __builtin_bit_cast(float, q.y & 0xffff0000u)};
                    const f32x4 x1v = (f32x4){__builtin_bit_cast(float, q.z << 16), __builtin_bit_cast(float, q.z & 0xffff0000u), __builtin_bit_cast(float, q.w << 16), __builtin_bit_cast(float, q.w & 0xffff0000u)};
                    const f32x4 v0 = x0 + gv[bj][0] * acc[ai][bj][m][0], v1 = x1v + gv[bj][1] * acc[ai][bj][m][1];
                    u32x4 w; w.x = cvt_pk_bf16(v0[0], v0[1]); w.y = cvt_pk_bf16(v0[2], v0[3]); w.z = cvt_pk_bf16(v1[0], v1[1]); w.w = cvt_pk_bf16(v1[2], v1[3]);
                    *(u32x4*)(out + off + bj * HALF) = w; } }
    }
};

template <bool ROUTER> struct EpiSwiglu {
    static constexpr bool PERM = true, AFTER_DRAIN = false;
    bf16_t* Act; float* logits; int pn_per;
    __device__ __forceinline__ void operator()(const f32x4 (&acc)[2][2][4][2], const Unit& u, int wr, int wc, int fr, int fq) const {
        const int row0 = u.pm * BM + wr * 64 + fr; const int ht = u.pn % pn_per;
        if (ROUTER && ht == 2) {
            if (wc < 2) {
#pragma unroll
                for (int ai = 0; ai < 2; ++ai)
#pragma unroll
                    for (int m = 0; m < 4; ++m) { float* rp = logits + (size_t)(row0 + ai * HALF + m * 16) * 64 + wc * 32 + 8 * fq;
                        *(f32x4*)rp = acc[ai][0][m][0]; *(f32x4*)(rp + 4) = acc[ai][0][m][1]; }
            }
            return;
        }
        const int col0 = ht * 128 + wc * 32 + 8 * fq;
#pragma unroll
        for (int ai = 0; ai < 2; ++ai)
#pragma unroll
            for (int m = 0; m < 4; ++m) { float v[8];
#pragma unroll
                for (int i = 0; i < 4; ++i) { v[i] = fsilu(acc[ai][0][m][0][i]) * acc[ai][1][m][0][i]; v[4 + i] = fsilu(acc[ai][0][m][1][i]) * acc[ai][1][m][1][i]; }
                u32x4 w; w.x = cvt_pk_bf16(v[0], v[1]); w.y = cvt_pk_bf16(v[2], v[3]); w.z = cvt_pk_bf16(v[4], v[5]); w.w = cvt_pk_bf16(v[6], v[7]);
                *(u32x4*)(Act + (size_t)(row0 + ai * HALF + m * 16) * 256 + col0) = w; }
    }
};

struct EpiDownY {
    static constexpr bool PERM = true, AFTER_DRAIN = false;
    unsigned char* Y;
    __device__ __forceinline__ void operator()(const f32x4 (&acc)[2][2][4][2], const Unit& u, int wr, int wc, int fr, int fq) const {
        typedef unsigned u32x2 __attribute__((ext_vector_type(2)));
        const int col0 = u.a2 * BM + wc * 32 + 8 * fq;
#pragma unroll
        for (int ai = 0; ai < 2; ++ai)
#pragma unroll
            for (int m = 0; m < 4; ++m) { const int r = ai * HALF + wr * 64 + m * 16 + fr;
                if (r < u.a1) { unsigned char* rowp = Y + (size_t)(u.a0 + r) * 1024 + col0;
#pragma unroll
                    for (int bj = 0; bj < 2; ++bj) { const f32x4 v0 = acc[ai][bj][m][0] * 8.0f, v1 = acc[ai][bj][m][1] * 8.0f;
                        int w0 = __builtin_amdgcn_cvt_pk_fp8_f32(v0[0], v0[1], 0, false); w0 = __builtin_amdgcn_cvt_pk_fp8_f32(v0[2], v0[3], w0, true);
                        int w1 = __builtin_amdgcn_cvt_pk_fp8_f32(v1[0], v1[1], 0, false); w1 = __builtin_amdgcn_cvt_pk_fp8_f32(v1[2], v1[3], w1, true);
                        *(u32x2*)(rowp + bj * HALF) = (u32x2){(unsigned)w0, (unsigned)w1}; } } }
    }
};

template <class Epi, class Sched, bool ALIGN_EPI = false, bool SP2 = false>
__device__ __forceinline__ void gemm_phase(PG8_LAS unsigned char* lds, const Gemm g, const Sched& S, const Epi& E) {
    const int tid = threadIdx.x, wid = __builtin_amdgcn_readfirstlane(tid >> 6), lane = tid & 63, wr = wid >> 2, wc = wid & 3, fr = lane & 15, fq = lane >> 4;
    const int K = Sched::HAS_KO ? Sched::LD : g.K, nt = g.K / BK;
    unsigned voffA[2], voffB[2];
#pragma unroll
    for (int i = 0; i < 2; ++i) { int R, C; stage_rc(tid * 16 + i * 8192, R, C); const int Rb = Epi::PERM ? ((R & ~31) + perm32(R & 31)) : R;
        voffA[i] = (unsigned)(R * K + C) * 2u; voffB[i] = (unsigned)(Rb * K + C) * 2u; }
    const size_t kstep = (size_t)(BK * 2);
    const size_t hstep = (size_t)HALF * K * 2;
    const size_t tstep = 2 * hstep;
    const unsigned ldsw = (unsigned)wid * 1024u;
    const int aoff = lds_byte(wr * 64 + fr, fq * 8), boff = lds_byte(wc * 32 + fr, fq * 8);
#define PG8_SA(b, h) (((b) * 2 + (h)) * HTB)
#define PG8_SB(b, h) ((4 + (b) * 2 + (h)) * HTB)
#define PG8_STAGE(bufoff, gbase, voff) do { _Pragma("unroll") for (int _i = 0; _i < 2; ++_i) \
        __builtin_amdgcn_global_load_lds((const unsigned*)((const char*)(gbase) + (voff)[_i]), (PG8_LAS unsigned*)(lds + (bufoff) + ldsw + _i * 8192), 16, 0, 0); } while (0)
#define PG8_LDA(dst, b, h) do { _Pragma("unroll") for (int m = 0; m < 4; ++m) _Pragma("unroll") for (int k = 0; k < 2; ++k) dst[m][k] = *(const PG8_LAS bf16x8*)(lds + PG8_SA(b, h) + aoff + m * 2048 + k * 1024); } while (0)
#define PG8_LDB(dst, b, h) do { _Pragma("unroll") for (int n = 0; n < 2; ++n) _Pragma("unroll") for (int k = 0; k < 2; ++k) dst[n][k] = *(const PG8_LAS bf16x8*)(lds + PG8_SB(b, h) + boff + n * 2048 + k * 1024); } while (0)
#define PG8_MMA(ai, bj, At, Bt) do { __builtin_amdgcn_s_setprio(1); _Pragma("unroll") for (int m = 0; m < 4; ++m) _Pragma("unroll") for (int n = 0; n < 2; ++n) _Pragma("unroll") for (int k = 0; k < 2; ++k) \
        acc[ai][bj][m][n] = __builtin_amdgcn_mfma_f32_16x16x32_bf16(Bt[n][k], At[m][k], acc[ai][bj][m][n], 0, 0, 0); __builtin_amdgcn_s_setprio(0); } while (0)
#define PG8_WAIT_V(n) asm volatile("s_waitcnt vmcnt(" #n ")" ::: "memory")
#define PG8_WAIT_L(n) asm volatile("s_waitcnt lgkmcnt(" #n ")" ::: "memory")
#define PG8_BAR __builtin_amdgcn_s_barrier()
#define PG8_SCHED __builtin_amdgcn_sched_barrier(0)
    Unit cur, nxt; int ui = 0;
    if (!S.next(0, cur)) return;
    f32x4 acc[2][2][4][2];
#pragma unroll
    for (int a = 0; a < 2; ++a)
#pragma unroll
        for (int b = 0; b < 2; ++b)
#pragma unroll
            for (int m = 0; m < 4; ++m)
#pragma unroll
                for (int n = 0; n < 2; ++n) acc[a][b][m][n] = (f32x4){0.f, 0.f, 0.f, 0.f};
    bf16x8 At[4][2], B0[2][2], B1[2][2];
    const size_t cko = Sched::HAS_KO ? (size_t)Sched::koff(cur) * 2 : (size_t)0; const char* cA = (const char*)g.A + (size_t)cur.pm * tstep + cko; const char* cB = (const char*)g.Bt + (size_t)cur.pn * tstep + cko;
    S.a_ready(cur);
    if constexpr (SP2) {
        PG8_STAGE(PG8_SB(0, 0), cB, voffB); PG8_STAGE(PG8_SB(0, 1), cB + hstep, voffB); PG8_STAGE(PG8_SA(0, 0), cA, voffA); PG8_STAGE(PG8_SA(0, 1), cA + hstep, voffA);
        if (wr == 1) PG8_BAR;
        PG8_WAIT_V(2); PG8_BAR;
        PG8_STAGE(PG8_SB(1, 0), cB + kstep, voffB); PG8_STAGE(PG8_SA(1, 0), cA + kstep, voffA); PG8_STAGE(PG8_SB(1, 1), cB + hstep + kstep, voffB);
        PG8_WAIT_V(6); PG8_BAR;
    } else {
        PG8_STAGE(PG8_SB(0, 0), cB, voffB); PG8_STAGE(PG8_SA(0, 0), cA, voffA); PG8_STAGE(PG8_SB(0, 1), cB + hstep, voffB); PG8_STAGE(PG8_SA(0, 1), cA + hstep, voffA);
        if (wr == 1) PG8_BAR;
        PG8_WAIT_V(4); PG8_BAR;
        PG8_STAGE(PG8_SB(1, 0), cB + kstep, voffB); PG8_STAGE(PG8_SA(1, 0), cA + kstep, voffA); PG8_STAGE(PG8_SB(1, 1), cB + hstep + kstep, voffB);
        PG8_WAIT_V(6); PG8_BAR;
    }
    for (;;) {
        const bool has_next = S.next(ui + 1, nxt);
        const bool half_m = Sched::TAILS ? (cur.a1 <= 128) : false;
        const size_t nko = (Sched::HAS_KO && has_next) ? (size_t)Sched::koff(nxt) * 2 : (size_t)0; const char* nA = has_next ? (const char*)g.A + (size_t)nxt.pm * tstep + nko : cA; const char* nB = has_next ? (const char*)g.Bt + (size_t)nxt.pn * tstep + nko : cB;
#pragma unroll 1
        for (int t = 0; t < nt; t += 2) {
            const bool last = (t == nt - 2);
            const char* a1 = cA + (size_t)(t + 1) * kstep;
            const char* a2 = last ? nA : cA + (size_t)(t + 2) * kstep; const char* b2 = last ? nB : cB + (size_t)(t + 2) * kstep;
            const char* a3 = a2 + kstep; const char* b3 = b2 + kstep;
            if (last && has_next) S.a_ready(nxt);
            if constexpr (SP2) {
            PG8_LDB(B0, 0, 0); PG8_LDB(B1, 0, 1); PG8_SCHED; PG8_LDA(At, 0, 0); PG8_STAGE(PG8_SA(1, 1), a1 + hstep, voffA);
            PG8_WAIT_V(8); PG8_WAIT_L(0); PG8_BAR; PG8_MMA(0, 0, At, B0); PG8_MMA(0, 1, At, B1); PG8_BAR; PG8_SCHED;
            PG8_LDA(At, 0, 1); PG8_STAGE(PG8_SB(0, 0), b2, voffB); PG8_STAGE(PG8_SB(0, 1), b2 + hstep, voffB); PG8_STAGE(PG8_SA(0, 0), a2, voffA);
            PG8_WAIT_V(8); PG8_WAIT_L(0); PG8_BAR; if (!half_m) { PG8_MMA(1, 0, At, B0); PG8_MMA(1, 1, At, B1); } PG8_BAR; PG8_SCHED;
            PG8_LDB(B0, 1, 0); PG8_LDB(B1, 1, 1); PG8_SCHED; PG8_LDA(At, 1, 0); PG8_STAGE(PG8_SA(0, 1), a2 + hstep, voffA);
            PG8_WAIT_V(8); PG8_WAIT_L(0); PG8_BAR; PG8_MMA(0, 0, At, B0); PG8_MMA(0, 1, At, B1); PG8_BAR; PG8_SCHED;
            PG8_LDA(At, 1, 1); PG8_STAGE(PG8_SB(1, 0), b3, voffB); PG8_STAGE(PG8_SB(1, 1), b3 + hstep, voffB); PG8_STAGE(PG8_SA(1, 0), a3, voffA);
            PG8_WAIT_V(8); PG8_WAIT_L(0); PG8_BAR; if (!half_m) { PG8_MMA(1, 0, At, B0); PG8_MMA(1, 1, At, B1); } PG8_BAR; PG8_SCHED;
            } else {
            PG8_LDB(B0, 0, 0); PG8_SCHED; PG8_LDA(At, 0, 0); PG8_STAGE(PG8_SA(1, 1), a1 + hstep, voffA);
            PG8_WAIT_L(8); PG8_BAR; PG8_WAIT_L(0); PG8_MMA(0, 0, At, B0); PG8_BAR; PG8_SCHED;
            PG8_LDB(B1, 0, 1); PG8_STAGE(PG8_SB(0, 0), b2, voffB);
            PG8_BAR; PG8_WAIT_L(0); PG8_MMA(0, 1, At, B1); PG8_BAR;
            PG8_LDA(At, 0, 1); PG8_STAGE(PG8_SA(0, 0), a2, voffA);
            PG8_BAR; PG8_WAIT_L(0); PG8_MMA(1, 0, At, B0); PG8_BAR; PG8_SCHED;
            PG8_STAGE(PG8_SB(0, 1), b2 + hstep, voffB);
            PG8_WAIT_V(6); PG8_BAR; PG8_MMA(1, 1, At, B1); PG8_BAR;
            PG8_LDB(B0, 1, 0); PG8_SCHED; PG8_LDA(At, 1, 0); PG8_STAGE(PG8_SA(0, 1), a2 + hstep, voffA);
            PG8_WAIT_L(8); PG8_BAR; PG8_WAIT_L(0); PG8_MMA(0, 0, At, B0); PG8_BAR; PG8_SCHED;
            PG8_LDB(B1, 1, 1); PG8_STAGE(PG8_SB(1, 0), b3, voffB);
            PG8_BAR; PG8_WAIT_L(0); PG8_MMA(0, 1, At, B1); PG8_BAR;
            PG8_LDA(At, 1, 1); PG8_STAGE(PG8_SA(1, 0), a3, voffA);
            PG8_BAR; PG8_WAIT_L(0); PG8_MMA(1, 0, At, B0); PG8_BAR; PG8_SCHED;
            PG8_STAGE(PG8_SB(1, 1), b3 + hstep, voffB);
            PG8_WAIT_V(6); PG8_BAR; PG8_MMA(1, 1, At, B1); PG8_BAR;
            }
        }
        if constexpr (ALIGN_EPI) { if (wr == 0) PG8_BAR; }
        if constexpr (!Epi::AFTER_DRAIN) { E(acc, cur, wr, wc, fr, fq); S.done(cur); }
        if (!has_next) break;
#pragma unroll
        for (int a = 0; a < 2; ++a)
#pragma unroll
            for (int b = 0; b < 2; ++b)
#pragma unroll
                for (int m = 0; m < 4; ++m)
#pragma unroll
                    for (int n = 0; n < 2; ++n) acc[a][b][m][n] = (f32x4){0.f, 0.f, 0.f, 0.f};
        cur = nxt; cA = nA; cB = nB; ++ui;
        if constexpr (ALIGN_EPI) { if (wr == 1) PG8_BAR; }
    }
    PG8_WAIT_V(0);
    if constexpr (!ALIGN_EPI) { if (wr == 0) PG8_BAR; }
    PG8_BAR;
    if constexpr (Epi::AFTER_DRAIN) { E.fused(acc, cur, wr, wc, fr, fq, lds, wid, lane); S.done(cur); }
#undef PG8_SA
#undef PG8_SB
#undef PG8_STAGE
#undef PG8_LDA
#undef PG8_LDB
#undef PG8_MMA
#undef PG8_WAIT_V
#undef PG8_WAIT_L
#undef PG8_BAR
#undef PG8_SCHED
}


template <class Epi, class Sched, bool ALIGN_EPI = false>
__device__ __forceinline__ void gemm_phase_gather(PG8_LAS unsigned char* lds, const Gemm g, const Sched& S, const Epi& E, const int* rowtok, PG8_LAS int* gtab) {
    const int tid = threadIdx.x, wid = __builtin_amdgcn_readfirstlane(tid >> 6), lane = tid & 63, wr = wid >> 2, wc = wid & 3, fr = lane & 15, fq = lane >> 4;
    const int K = g.K, nt = K / BK;
    unsigned voffB[2], pcol[2]; int prow[2];
#pragma unroll
    for (int i = 0; i < 2; ++i) { int R, C; stage_rc(tid * 16 + i * 8192, R, C); const int Rb = Epi::PERM ? ((R & ~31) + perm32(R & 31)) : R;
        prow[i] = R; pcol[i] = (unsigned)C * 2u; voffB[i] = (unsigned)(Rb * K + C) * 2u; }
    const size_t kstep = (size_t)(BK * 2);
    const size_t hstep = (size_t)HALF * K * 2;
    const size_t tstep = 2 * hstep;
    const unsigned ldsw = (unsigned)wid * 1024u;
    const unsigned rowb = (unsigned)K * 2u;
    const int aoff = lds_byte(wr * 64 + fr, fq * 8), boff = lds_byte(wc * 32 + fr, fq * 8);
#define PG8_SA(b, h) (((b) * 2 + (h)) * HTB)
#define PG8_SB(b, h) ((4 + (b) * 2 + (h)) * HTB)
#define PG8_STAGE(bufoff, gbase, voff) do { _Pragma("unroll") for (int _i = 0; _i < 2; ++_i) \
        __builtin_amdgcn_global_load_lds((const unsigned*)((const char*)(gbase) + (voff)[_i]), (PG8_LAS unsigned*)(lds + (bufoff) + ldsw + _i * 8192), 16, 0, 0); } while (0)
#define PG8_LDA(dst, b, h) do { _Pragma("unroll") for (int m = 0; m < 4; ++m) _Pragma("unroll") for (int k = 0; k < 2; ++k) dst[m][k] = *(const PG8_LAS bf16x8*)(lds + PG8_SA(b, h) + aoff + m * 2048 + k * 1024); } while (0)
#define PG8_LDB(dst, b, h) do { _Pragma("unroll") for (int n = 0; n < 2; ++n) _Pragma("unroll") for (int k = 0; k < 2; ++k) dst[n][k] = *(const PG8_LAS bf16x8*)(lds + PG8_SB(b, h) + boff + n * 2048 + k * 1024); } while (0)
#define PG8_MMA(ai, bj, At, Bt) do { __builtin_amdgcn_s_setprio(1); _Pragma("unroll") for (int m = 0; m < 4; ++m) _Pragma("unroll") for (int n = 0; n < 2; ++n) _Pragma("unroll") for (int k = 0; k < 2; ++k) \
        acc[ai][bj][m][n] = __builtin_amdgcn_mfma_f32_16x16x32_bf16(Bt[n][k], At[m][k], acc[ai][bj][m][n], 0, 0, 0); __builtin_amdgcn_s_setprio(0); } while (0)
#define PG8_WAIT_V(n) asm volatile("s_waitcnt vmcnt(" #n ")" ::: "memory")
#define PG8_WAIT_L(n) asm volatile("s_waitcnt lgkmcnt(" #n ")" ::: "memory")
#define PG8_BAR __builtin_amdgcn_s_barrier()
#define PG8_SCHED __builtin_amdgcn_sched_barrier(0)
    Unit cur, nxt; int ui = 0;
    if (!S.next(0, cur)) return;
    if (tid < 256) gtab[tid] = (tid < cur.a1) ? rowtok[cur.a0 + tid] : 0;
    __syncthreads();
    unsigned cva[2][2], nva[2][2];
#pragma unroll
    for (int h = 0; h < 2; ++h)
#pragma unroll
        for (int i = 0; i < 2; ++i) { cva[h][i] = (unsigned)gtab[h * HALF + prow[i]] * rowb + pcol[i]; nva[h][i] = cva[h][i]; }
    f32x4 acc[2][2][4][2];
#pragma unroll
    for (int a = 0; a < 2; ++a)
#pragma unroll
        for (int b = 0; b < 2; ++b)
#pragma unroll
            for (int m = 0; m < 4; ++m)
#pragma unroll
                for (int n = 0; n < 2; ++n) acc[a][b][m][n] = (f32x4){0.f, 0.f, 0.f, 0.f};
    bf16x8 At[4][2], B0[2][2], B1[2][2];
    const char* gA = (const char*)g.A; const char* cB = (const char*)g.Bt + (size_t)cur.pn * tstep;
    PG8_STAGE(PG8_SB(0, 0), cB, voffB); PG8_STAGE(PG8_SB(0, 1), cB + hstep, voffB); PG8_STAGE(PG8_SA(0, 0), gA, cva[0]); PG8_STAGE(PG8_SA(0, 1), gA, cva[1]);
    if (wr == 1) PG8_BAR;
    PG8_WAIT_V(2); PG8_BAR;
    PG8_STAGE(PG8_SB(1, 0), cB + kstep, voffB); PG8_STAGE(PG8_SA(1, 0), gA + kstep, cva[0]); PG8_STAGE(PG8_SB(1, 1), cB + hstep + kstep, voffB);
    PG8_WAIT_V(6); PG8_BAR;
    for (;;) {
        const bool has_next = S.next(ui + 1, nxt);
        const bool half_m = Sched::TAILS ? (cur.a1 <= 128) : false;
        const char* nB = has_next ? (const char*)g.Bt + (size_t)nxt.pn * tstep : cB;
#pragma unroll 1
        for (int t = 0; t < nt; t += 2) {
            const bool last = (t == nt - 2);
            if (t == 0 && has_next && wid < 4) {
                const int r = wid * 64 + lane;
                __builtin_amdgcn_global_load_lds((const unsigned*)(rowtok + nxt.a0 + r), (PG8_LAS unsigned*)(gtab + ((ui + 1) & 1) * 256 + wid * 64), 4, 0, 0);
            }
            if (last && has_next) {
                PG8_LAS int* tb = gtab + ((ui + 1) & 1) * 256;
#pragma unroll
                for (int h = 0; h < 2; ++h)
#pragma unroll
                    for (int i = 0; i < 2; ++i) { const int r = h * HALF + prow[i]; const int tok = (r < nxt.a1) ? tb[r] : 0; nva[h][i] = (unsigned)tok * rowb + pcol[i]; }
            }
            const char* a1 = gA + (size_t)(t + 1) * kstep;
            const char* a2 = last ? gA : gA + (size_t)(t + 2) * kstep; const char* b2 = last ? nB : cB + (size_t)(t + 2) * kstep;
            const char* a3 = a2 + kstep; const char* b3 = b2 + kstep;
            unsigned v2[2][2];
#pragma unroll
            for (int h = 0; h < 2; ++h)
#pragma unroll
                for (int i = 0; i < 2; ++i) v2[h][i] = last ? nva[h][i] : cva[h][i];
            PG8_LDB(B0, 0, 0); PG8_LDB(B1, 0, 1); PG8_SCHED; PG8_LDA(At, 0, 0); PG8_STAGE(PG8_SA(1, 1), a1, cva[1]);
            PG8_WAIT_V(8); PG8_WAIT_L(0); PG8_BAR; PG8_MMA(0, 0, At, B0); PG8_MMA(0, 1, At, B1); PG8_BAR; PG8_SCHED;
            PG8_LDA(At, 0, 1); PG8_STAGE(PG8_SB(0, 0), b2, voffB); PG8_STAGE(PG8_SB(0, 1), b2 + hstep, voffB); PG8_STAGE(PG8_SA(0, 0), a2, v2[0]);
            PG8_WAIT_V(8); PG8_WAIT_L(0); PG8_BAR; if (!half_m) { PG8_MMA(1, 0, At, B0); PG8_MMA(1, 1, At, B1); } PG8_BAR; PG8_SCHED;
            PG8_LDB(B0, 1, 0); PG8_LDB(B1, 1, 1); PG8_SCHED; PG8_LDA(At, 1, 0); PG8_STAGE(PG8_SA(0, 1), a2, v2[1]);
            PG8_WAIT_V(8); PG8_WAIT_L(0); PG8_BAR; PG8_MMA(0, 0, At, B0); PG8_MMA(0, 1, At, B1); PG8_BAR; PG8_SCHED;
            PG8_LDA(At, 1, 1); PG8_STAGE(PG8_SB(1, 0), b3, voffB); PG8_STAGE(PG8_SB(1, 1), b3 + hstep, voffB); PG8_STAGE(PG8_SA(1, 0), a3, v2[0]);
            PG8_WAIT_V(8); PG8_WAIT_L(0); PG8_BAR; if (!half_m) { PG8_MMA(1, 0, At, B0); PG8_MMA(1, 1, At, B1); } PG8_BAR; PG8_SCHED;
        }
        if constexpr (ALIGN_EPI) { if (wr == 0) PG8_BAR; }
        E(acc, cur, wr, wc, fr, fq);
        if (!has_next) break;
#pragma unroll
        for (int a = 0; a < 2; ++a)
#pragma unroll
            for (int b = 0; b < 2; ++b)
#pragma unroll
                for (int m = 0; m < 4; ++m)
#pragma unroll
                    for (int n = 0; n < 2; ++n) acc[a][b][m][n] = (f32x4){0.f, 0.f, 0.f, 0.f};
        cur = nxt; cB = nB; ++ui;
#pragma unroll
        for (int h = 0; h < 2; ++h)
#pragma unroll
            for (int i = 0; i < 2; ++i) cva[h][i] = nva[h][i];
        if constexpr (ALIGN_EPI) { if (wr == 1) PG8_BAR; }
    }
    PG8_WAIT_V(0);
    if constexpr (!ALIGN_EPI) { if (wr == 0) PG8_BAR; }
    PG8_BAR;
#undef PG8_SA
#undef PG8_SB
#undef PG8_STAGE
#undef PG8_LDA
#undef PG8_LDB
#undef PG8_MMA
#undef PG8_WAIT_V
#undef PG8_WAIT_L
#undef PG8_BAR
#undef PG8_SCHED
}

}


constexpr int NWAVES = 8;
constexpr int BATCH = 2, SEQ = 8192, D = 1024, M = BATCH * SEQ;
constexpr int NSH = 1792, DIN = 2816, DR = 512, DSG = 512, NH = 8, HS = 64;
constexpr int NEXP = 64, TOPK = 8, DE = 256, ECAP = 16384;
constexpr int MOD_KC = 16;
constexpr float RMS_EPS = 1e-6f;

constexpr size_t MiB = 1u << 20;
constexpr size_t WS_CTL = 0, CTL_ZERO_BYTES = 128 * 1024;
constexpr size_t WS_WIN   = 1 * MiB;
constexpr size_t WS_WOUT  = WS_WIN + (size_t)DIN * D * 2;
constexpr size_t WS_WS13  = WS_WOUT + (size_t)D * D * 2;
constexpr size_t WS_WS2   = WS_WS13 + (size_t)768 * D * 2;
constexpr size_t WS_WLORA = WS_WS2 + (size_t)D * 256 * 2;
constexpr size_t WS_WSP   = WS_WLORA + (size_t)1536 * 256 * 2;
constexpr size_t WS_MODP  = WS_WSP + (size_t)8 * 128 * 128 * 2;
constexpr size_t WS_MODF  = WS_MODP + (size_t)MOD_KC * 2 * 6144 * 4;
constexpr size_t WS_BONUS = WS_MODF + (size_t)2 * 6144 * 4;
constexpr size_t WS_SGST  = WS_BONUS + (size_t)M * 8 * 4;
constexpr size_t WS_SMALL_END = WS_SGST + (size_t)M * 2 * 4;
static_assert(WS_SMALL_END <= 14 * MiB, "small region");
constexpr size_t WS_PROJ = 14 * MiB;
constexpr size_t WS_LW   = 102 * MiB;
constexpr size_t WS_AB   = 118 * MiB;
constexpr size_t WS_GB   = 134 * MiB;
constexpr size_t WS_HBUF = 150 * MiB;
constexpr size_t WS_LIN  = 150 * MiB;
constexpr size_t WS_AH   = 150 * MiB;
constexpr size_t WS_UH   = 166 * MiB;
constexpr size_t WS_PM   = 182 * MiB;
constexpr size_t WS_QM   = 198 * MiB;
constexpr size_t WS_H0   = 230 * MiB;
constexpr size_t WS_YCAT = 246 * MiB;
constexpr size_t WS_WE2  = 14 * MiB;
constexpr size_t WS_LOGIT= 46 * MiB;
constexpr size_t WS_ROWTOK = 50 * MiB;
constexpr size_t WS_SLOT = 54 * MiB;
constexpr size_t WS_WT   = 55 * MiB;
constexpr size_t WS_ACT  = 56 * MiB;
constexpr size_t WS_ACTS = 128 * MiB;
constexpr size_t WS_WE13 = 136 * MiB;
constexpr size_t WS_H2   = 200 * MiB;
constexpr size_t WS_Y    = 136 * MiB;
constexpr size_t WS_SH   = 264 * MiB;
constexpr size_t WS_END  = 296 * MiB;
constexpr int ACT_ROWS = 147456;
constexpr int CW_BAR = 4096;
constexpr int CW_CVQ = 16256;
constexpr int CW_CVQ2 = 16288;
constexpr int CW_SGUQ = 16320;
constexpr int CW_ECNT = 16384;

constexpr int RING_OFF = 0, RING_BYTES = 131072;
constexpr int LDSX_OFF = RING_BYTES;
constexpr int LX_GTAB = LDSX_OFF;
constexpr int LX_TTAB = LDSX_OFF + 2048;
constexpr int LX_ECNT = LDSX_OFF + 2048 + 2816;
constexpr int LDSCTL_OFF = RING_BYTES + 12288, MISC_OFF = LDSCTL_OFF + 320;
constexpr int LDS_BYTES = 147456;
static_assert(MISC_OFF + 128 <= LDS_BYTES, "LDS map");

#define GAS __attribute__((address_space(1)))
#define LAS __attribute__((address_space(3)))
typedef unsigned short bf16;
typedef unsigned v4u __attribute__((ext_vector_type(4)));
typedef unsigned v2u __attribute__((ext_vector_type(2)));
typedef float f32x4 __attribute__((ext_vector_type(4)));
typedef short bf16x8 __attribute__((ext_vector_type(8)));
typedef GAS unsigned gu32;
#define RLX_AGENT __ATOMIC_RELAXED, __HIP_MEMORY_SCOPE_AGENT
#define LDS_WAIT() asm volatile("s_waitcnt lgkmcnt(0)" ::: "memory")
#define VM_WAIT() asm volatile("s_waitcnt vmcnt(0)" ::: "memory")
#define LBAR() do { asm volatile("s_waitcnt lgkmcnt(0)" ::: "memory"); __builtin_amdgcn_s_barrier(); asm volatile("" ::: "memory"); } while (0)
typedef __bf16 bf16n2 __attribute__((ext_vector_type(2)));
__device__ __forceinline__ unsigned f2bf(float f) { return (unsigned)__builtin_bit_cast(unsigned short, (__bf16)f); }
__device__ __forceinline__ unsigned pk2(float lo, float hi) { bf16n2 v; v.x = (__bf16)lo; v.y = (__bf16)hi; return __builtin_bit_cast(unsigned, v); }
__device__ __forceinline__ float bf2f(unsigned short h) { return __builtin_bit_cast(float, (unsigned)h << 16); }
__device__ __forceinline__ float bflo(unsigned w) { return __builtin_bit_cast(float, w << 16); }
__device__ __forceinline__ float bfhi(unsigned w) { return __builtin_bit_cast(float, w & 0xffff0000u); }
__device__ __forceinline__ float fsig(float x) { return __builtin_amdgcn_rcpf(1.0f + __expf(-x)); }
__device__ __forceinline__ float fgelu(float x) { return x * fsig(1.5957691216f * (x + 0.044715f * x * x * x)); }
__device__ __forceinline__ float dpp_scan_add(float x) {
    int v;
    v = __builtin_amdgcn_update_dpp(0, __builtin_bit_cast(int, x), 0x111, 0xf, 0xf, true); x += __builtin_bit_cast(float, v);
    v = __builtin_amdgcn_update_dpp(0, __builtin_bit_cast(int, x), 0x112, 0xf, 0xf, true); x += __builtin_bit_cast(float, v);
    v = __builtin_amdgcn_update_dpp(0, __builtin_bit_cast(int, x), 0x114, 0xf, 0xf, true); x += __builtin_bit_cast(float, v);
    v = __builtin_amdgcn_update_dpp(0, __builtin_bit_cast(int, x), 0x118, 0xf, 0xf, true); x += __builtin_bit_cast(float, v);
    v = __builtin_amdgcn_update_dpp(0, __builtin_bit_cast(int, x), 0x142, 0xa, 0xf, false); x += __builtin_bit_cast(float, v);
    v = __builtin_amdgcn_update_dpp(0, __builtin_bit_cast(int, x), 0x143, 0xc, 0xf, false); x += __builtin_bit_cast(float, v);
    return x;
}
__device__ __forceinline__ float row16_sum(float x) {
    int v;
    v = __builtin_amdgcn_update_dpp(0, __builtin_bit_cast(int, x), 0x128, 0xf, 0xf, false); x += __builtin_bit_cast(float, v);
    v = __builtin_amdgcn_update_dpp(0, __builtin_bit_cast(int, x), 0x124, 0xf, 0xf, false); x += __builtin_bit_cast(float, v);
    v = __builtin_amdgcn_update_dpp(0, __builtin_bit_cast(int, x), 0x122, 0xf, 0xf, false); x += __builtin_bit_cast(float, v);
    v = __builtin_amdgcn_update_dpp(0, __builtin_bit_cast(int, x), 0x121, 0xf, 0xf, false); x += __builtin_bit_cast(float, v);
    return x;
}
__device__ __forceinline__ float wave_sum(float v) {
    return __builtin_bit_cast(float, __builtin_amdgcn_readlane(__builtin_bit_cast(int, dpp_scan_add(v)), 63));
}

#define XB_TMO      128
#define XB_XCNT(j)  (256  + 64 * (j))
#define XB_XSUB(j)  (1280 + 64 * (j))
#define XB_XGEN(j)  (2304 + 64 * (j))
#define XB_TOP      3328
#define XB_TOPGEN   3392
#define XCD_BAR_WORDS 3456
#define XB_SPIN_CAP (1u << 18)
__device__ __forceinline__ unsigned xb_ld(unsigned* p)              { return __hip_atomic_load(p, __ATOMIC_RELAXED, __HIP_MEMORY_SCOPE_AGENT); }
__device__ __forceinline__ unsigned xb_add(unsigned* p, unsigned v) { return __hip_atomic_fetch_add(p, v, __ATOMIC_RELAXED, __HIP_MEMORY_SCOPE_AGENT); }
__device__ __forceinline__ unsigned xb_xcc_id() { return (unsigned)__builtin_amdgcn_s_getreg((3 << 11) | 20) & 0xFu; }
#define XB_SPIN(cond, bar) do { unsigned _sp = 0; while (cond) { __builtin_amdgcn_s_sleep(1); \
    if ((++_sp & 255u) == 0u) { if (xb_ld(&(bar)[XB_TMO])) break; if (_sp > XB_SPIN_CAP) { atomicAdd(&(bar)[XB_TMO], 1u); break; } } } } while (0)
struct XcdBarrier { unsigned* bar; unsigned x; volatile LAS unsigned* st; };
__device__ __forceinline__ XcdBarrier xcd_barrier_post(unsigned* bar, volatile LAS unsigned* st) {
    XcdBarrier b; b.bar = bar; b.x = xb_xcc_id(); b.st = st;
    if (threadIdx.x == 0) (void)xb_add(&bar[XB_XCNT(b.x)], 1u);
    return b;
}
__device__ __forceinline__ void xcd_barrier_complete(unsigned* bar, unsigned x, unsigned& nloc, unsigned& nx) {
    const unsigned G = gridDim.x * gridDim.y * gridDim.z;
    unsigned sum, cnt, mine, sp = 0u;
    for (;;) {
        sum = 0u; cnt = 0u; mine = 0u;
#pragma unroll
        for (unsigned j = 0; j < 16; ++j) { const unsigned c = xb_ld(&bar[XB_XCNT(j)]); sum += c; cnt += (c > 0u) ? 1u : 0u; mine = (j == x) ? c : mine; }
        if (sum == G) break;
        __builtin_amdgcn_s_sleep(1);
        if ((++sp & 255u) == 0u) { if (xb_ld(&bar[XB_TMO])) break; if (sp > XB_SPIN_CAP) { atomicAdd(&bar[XB_TMO], 1u); break; } }
    }
    nloc = mine > 0u ? mine : 1u; nx = cnt > 0u ? cnt : 1u;
}
__device__ __forceinline__ void xcd_barrier(const XcdBarrier& b) {
    asm volatile("s_waitcnt vmcnt(0)" ::: "memory");
    __syncthreads();
    if (threadIdx.x == 0) {
        unsigned* bar = b.bar;
        __builtin_amdgcn_s_waitcnt(0);
        unsigned nloc = b.st[0], nx = b.st[1];
        if (nloc == 0u) { xcd_barrier_complete(bar, b.x, nloc, nx); b.st[0] = nloc; b.st[1] = nx; }
        const unsigned old = xb_add(&bar[XB_XSUB(b.x)], 1u);
        const unsigned gen = old / nloc;
        if (old + 1u == (gen + 1u) * nloc) {
            __builtin_amdgcn_fence(__ATOMIC_RELEASE, "agent");
            asm volatile("s_waitcnt vmcnt(0)" ::: "memory");
            const unsigned og = xb_add(&bar[XB_TOP], 1u);
            const unsigned tg = og / nx;
            if (og + 1u == (tg + 1u) * nx) { xb_add(&bar[XB_TOPGEN], 1u); __builtin_amdgcn_fence(__ATOMIC_ACQUIRE, "agent"); }
            else { __builtin_amdgcn_fence(__ATOMIC_ACQUIRE, "agent"); XB_SPIN(xb_ld(&bar[XB_TOPGEN]) == tg, bar); }
            asm volatile("s_waitcnt vmcnt(0)" ::: "memory");
        } else {
            __builtin_amdgcn_fence(__ATOMIC_ACQUIRE, "agent");
            XB_SPIN(xb_ld(&bar[XB_TOPGEN]) == gen, bar);
            asm volatile("s_waitcnt vmcnt(0)" ::: "memory");
        }
    }
    __syncthreads();
}

struct Frame {
    LAS unsigned char* lds;
    volatile LAS unsigned* MISC;
    gu32* ctl;
    int tid, lane, wave;
    int vcu, G;
    unsigned char* ws;
    float* out;
};

template <bool NT = false> __device__ __forceinline__ void transpose_item(const float* W, int K, int N, bf16* WT, int k0, int n0, int dst_row0, LAS float* scr, int lane) {
#pragma unroll 8
    for (int i = 0; i < 32; ++i) { const int kk = 2 * i + (lane >> 5); const float* src = W + (size_t)(k0 + kk) * N + n0 + (lane & 31); scr[kk * 33 + (lane & 31)] = NT ? __builtin_nontemporal_load(src) : *src; }
    LDS_WAIT(); asm volatile("" ::: "memory");
    const int c = lane & 7;
#pragma unroll
    for (int j = 0; j < 4; ++j) { const int n = (lane >> 3) + 8 * j; const LAS float* s = scr + (8 * c) * 33 + n;
        v4u o; o.x = pk2(s[0 * 33], s[1 * 33]); o.y = pk2(s[2 * 33], s[3 * 33]); o.z = pk2(s[4 * 33], s[5 * 33]); o.w = pk2(s[6 * 33], s[7 * 33]);
        GAS v4u* dst = (GAS v4u*)(WT + (size_t)(dst_row0 + n) * K + k0 + 8 * c); if (NT) __builtin_nontemporal_store(o, dst); else *dst = o; }
    LDS_WAIT(); asm volatile("" ::: "memory");
}
__device__ __forceinline__ int swiglu_row(int n, int which) { return (n >> 7) * 256 + which * 128 + (n & 127); }


struct Args { const float* in[32]; float* out; unsigned char* ws; int ph_lo, ph_hi, li, pad; };

__device__ __forceinline__ void p0_late(Frame& F, const Args& a, int bi, int nb_) {
    LAS float* scr = (LAS float*)(F.lds + RING_OFF + F.wave * 16384);
    const int gw = bi * NWAVES + F.wave, NGW = nb_ * NWAVES;
    bf16* Wout_t = (bf16*)(F.ws + WS_WOUT); bf16* WS13 = (bf16*)(F.ws + WS_WS13); bf16* WS2 = (bf16*)(F.ws + WS_WS2);
    constexpr int I_OUT = 16 * 32, I_S1 = 16 * 8, I_R = 16 * 2, I_S2 = 4 * 32;
    constexpr int NITEMS = I_OUT + 2 * I_S1 + I_R + I_S2;
    for (int it = gw; it < NITEMS; it += NGW) {
        int r = it;
        if (r < I_OUT) { const int kb = r / 32, nb = r % 32;
            transpose_item(a.in[21], 1024, 1024, Wout_t, 64 * kb, 32 * nb, 32 * nb, scr, F.lane); continue; } r -= I_OUT;
        if (r < I_S1) { const int kb = r / 8, nb = r % 8; transpose_item(a.in[28], 1024, 256, WS13, 64 * kb, 32 * nb, swiglu_row(32 * nb, 0), scr, F.lane); continue; } r -= I_S1;
        if (r < I_S1) { const int kb = r / 8, nb = r % 8; transpose_item(a.in[29], 1024, 256, WS13, 64 * kb, 32 * nb, swiglu_row(32 * nb, 1), scr, F.lane); continue; } r -= I_S1;
        if (r < I_R) { const int kb = r / 2, nb = r % 2; transpose_item(a.in[23], 1024, 64, WS13, 64 * kb, 32 * nb, 512 + 32 * nb, scr, F.lane); continue; } r -= I_R;
        { const int kb = r / 32, nb = r % 32; transpose_item(a.in[30], 256, 1024, WS2, 64 * kb, 32 * nb, 32 * nb, scr, F.lane); }
    }
    { bf16* Wl = (bf16*)(F.ws + WS_WLORA); const float* wd = a.in[8]; const float* wa = a.in[10]; const float* wg = a.in[11];
      for (int it = gw; it < 64; it += NGW) {
          if (it < 16) transpose_item(wd, 256, 512, Wl, 0, 32 * it, 32 * it, scr, F.lane);
          else if (it < 32) transpose_item(wa - 64 * 512, 256, 512, Wl, 64, 32 * (it - 16), 512 + 32 * (it - 16), scr, F.lane);
          else { const int q = it - 32, kb = q >> 4, nb = q & 15; transpose_item(wg - 128 * 512, 256, 512, Wl, 128 + 64 * kb, 32 * nb, 1024 + 32 * nb, scr, F.lane); } }
      for (int idx = bi * 512 + F.tid; idx < 8192; idx += nb_ * 512) { const int hi = idx >> 12, r = (idx >> 3) & 511, c = idx & 7;
          *(GAS v4u*)(Wl + (size_t)(hi * 512 + r) * 256 + (hi ? 0 : 64) + 8 * c) = (v4u){0u, 0u, 0u, 0u}; } }
    { bf16* Wsp = (bf16*)(F.ws + WS_WSP); const float* w = a.in[19];
      for (int idx = bi * 512 + F.tid; idx < 8 * 128 * 128; idx += nb_ * 512) {
          const int t = (idx >> 7) & 127, s = idx & 127; const float v = (t < 64 && s >= 64) ? 0.f : w[idx]; Wsp[idx] = (bf16)f2bf(v); } }
    __syncthreads();
}
__device__ __forceinline__ void p0_prologue(Frame& F, const Args& a) {
    LAS float* scr = (LAS float*)(F.lds + RING_OFF + F.wave * 16384);
    const int gw = F.vcu * NWAVES + F.wave, NGW = F.G * NWAVES;
    bf16* Win_t = (bf16*)(F.ws + WS_WIN);
    constexpr int I_IN = 16 * 88;
    for (int it = gw; it < I_IN; it += NGW) { const int kb = it / 88, nb = it % 88; transpose_item(a.in[5], 1024, DIN, Win_t, 64 * kb, 32 * nb, 32 * nb, scr, F.lane); }
    { float* modp = (float*)(F.ws + WS_MODP); const float* c = a.in[1]; const float* wada = a.in[2];
      for (int it = gw; it < 96 * MOD_KC; it += NGW) {
          const int cg = it % 96, kc = it / 96, j = cg * 64 + F.lane; float a0 = 0.f, a1 = 0.f;
#pragma unroll 8
          for (int kk = 0; kk < 64; ++kk) { const int k = kc * 64 + kk; const float w = wada[(size_t)k * 6144 + j]; const float c0 = c[k], c1 = c[1024 + k];
              a0 += c0 * fsig(c0) * w; a1 += c1 * fsig(c1) * w; }
          modp[(size_t)(kc * 2 + 0) * 6144 + j] = a0; modp[(size_t)(kc * 2 + 1) * 6144 + j] = a1; } }
}

__device__ __forceinline__ void norm_row_to_bf16(const float* xrow, bf16* orow, const LAS float* ga, const LAS float* sh, int lane) {
    const GAS f32x4* xr = (const GAS f32x4*)xrow + lane;
    f32x4 v[4]; float s = 0.f;
#pragma unroll
    for (int j = 0; j < 4; ++j) { v[j] = xr[64 * j]; s += (v[j].x * v[j].x + v[j].y * v[j].y) + (v[j].z * v[j].z + v[j].w * v[j].w); }
    const float rstd = __builtin_amdgcn_rsqf(wave_sum(s) * (1.f / D) + RMS_EPS);
    GAS unsigned long long* o8 = (GAS unsigned long long*)orow + lane;
#pragma unroll
    for (int j = 0; j < 4; ++j) { const f32x4 g = *(const LAS f32x4*)(ga + 4 * lane + 256 * j), b = *(const LAS f32x4*)(sh + 4 * lane + 256 * j);
        const f32x4 o = v[j] * rstd * g + b;
        o8[64 * j] = (unsigned long long)pk2(o.x, o.y) | ((unsigned long long)pk2(o.z, o.w) << 32); }
}

__device__ __forceinline__ void norm_row_bf16_to_bf16(const bf16* xrow, bf16* orow, const LAS float* ga, const LAS float* sh, int lane) {
    float v[2][8]; float s = 0.f;
#pragma unroll
    for (int jj = 0; jj < 2; ++jj) { const v4u q = *(const GAS v4u*)(xrow + 8 * lane + 512 * jj);
        v[jj][0] = bflo(q.x); v[jj][1] = bfhi(q.x); v[jj][2] = bflo(q.y); v[jj][3] = bfhi(q.y); v[jj][4] = bflo(q.z); v[jj][5] = bfhi(q.z); v[jj][6] = bflo(q.w); v[jj][7] = bfhi(q.w);
#pragma unroll
        for (int i = 0; i < 8; ++i) s += v[jj][i] * v[jj][i]; }
    const float rstd = __builtin_amdgcn_rsqf(wave_sum(s) * (1.f / D) + RMS_EPS);
#pragma unroll
    for (int jj = 0; jj < 2; ++jj) { const int c0 = 8 * lane + 512 * jj; float o[8];
#pragma unroll
        for (int q = 0; q < 2; ++q) { const f32x4 g = *(const LAS f32x4*)(ga + c0 + 4 * q), b = *(const LAS f32x4*)(sh + c0 + 4 * q);
            o[4 * q + 0] = v[jj][4 * q + 0] * rstd * g.x + b.x; o[4 * q + 1] = v[jj][4 * q + 1] * rstd * g.y + b.y; o[4 * q + 2] = v[jj][4 * q + 2] * rstd * g.z + b.z; o[4 * q + 3] = v[jj][4 * q + 3] * rstd * g.w + b.w; }
        v4u pk; pk.x = pk2(o[0], o[1]); pk.y = pk2(o[2], o[3]); pk.z = pk2(o[4], o[5]); pk.w = pk2(o[6], o[7]);
        *(GAS v4u*)(orow + c0) = pk; }
}

__device__ __forceinline__ void p1_h(Frame& F, const Args& a) {
    LAS float* ga = (LAS float*)(F.lds);
    LAS float* sh = (LAS float*)(F.lds + 8192);
    const float* modp = (const float*)(F.ws + WS_MODP); const float* bada = a.in[3]; const float* g1n = a.in[4];
    for (int idx = F.tid; idx < 2048; idx += 512) {
        const int b = idx >> 10, k = idx & 1023; float s0 = bada[k], s1 = bada[1024 + k];
#pragma unroll
        for (int kc = 0; kc < MOD_KC; ++kc) { s0 += modp[(size_t)(kc * 2 + b) * 6144 + k]; s1 += modp[(size_t)(kc * 2 + b) * 6144 + 1024 + k]; }
        sh[idx] = s0; ga[idx] = g1n[k] * (1.f + s1);
    }
    { float* modf = (float*)(F.ws + WS_MODF);
      for (int idx = (int)blockIdx.x * 512 + F.tid; idx < 2 * 6144; idx += F.G * 512) {
          const int b = idx / 6144, j = idx % 6144; float s = bada[j];
#pragma unroll
          for (int kc = 0; kc < MOD_KC; ++kc) s += modp[(size_t)(kc * 2 + b) * 6144 + j];
          modf[idx] = s; } }
    LDS_WAIT(); __syncthreads();
    const int gw = F.vcu * NWAVES + F.wave, NGW = F.G * NWAVES;
    const float* x = a.in[0]; bf16* H = (bf16*)(F.ws + WS_HBUF);
    for (int m = gw; m < M; m += NGW) { const int b = m >> 13; norm_row_to_bf16(x + (size_t)m * D, H + (size_t)m * D, ga + b * 1024, sh + b * 1024, F.lane); }
    __syncthreads();
}

__device__ __forceinline__ void p9_h2(Frame& F, const Args& a) {
    LAS float* ga = (LAS float*)(F.lds);
    LAS float* sh = (LAS float*)(F.lds + 8192);
    const float* modf = (const float*)(F.ws + WS_MODF); const float* g2n = a.in[22];
    for (int idx = F.tid; idx < 2048; idx += 512) { const int b = idx >> 10, k = idx & 1023; sh[idx] = modf[b * 6144 + 3072 + k]; ga[idx] = g2n[k] * (1.f + modf[b * 6144 + 4096 + k]); }
    LDS_WAIT(); __syncthreads();
    const int gw = F.vcu * NWAVES + F.wave, NGW = F.G * NWAVES;
    const bf16* x1 = (const bf16*)F.out; bf16* H = (bf16*)(F.ws + WS_H2);
    for (int m = gw; m < M; m += NGW) { const int b = m >> 13; norm_row_bf16_to_bf16(x1 + (size_t)m * D, H + (size_t)m * D, ga + b * 1024, sh + b * 1024, F.lane); }
    __syncthreads();
}

constexpr int VT_STRIDE = 136;
__device__ __forceinline__ void gelu8(const v4u q, float (&g)[8]) { g[0] = fgelu(bflo(q.x)); g[1] = fgelu(bfhi(q.x)); g[2] = fgelu(bflo(q.y)); g[3] = fgelu(bfhi(q.y)); g[4] = fgelu(bflo(q.z)); g[5] = fgelu(bfhi(q.z)); g[6] = fgelu(bflo(q.w)); g[7] = fgelu(bfhi(q.w)); }
__device__ __forceinline__ void sgu_item(Frame& F, const Args& a, int item) {
    const int nb = item >> 2, hp = item & 3, m0 = nb * 128;
    const bf16* proj = (const bf16*)(F.ws + WS_PROJ); bf16* Ycat = (bf16*)(F.ws + WS_YCAT); const bf16* Wsp = (const bf16*)(F.ws + WS_WSP);
    const float* lng = a.in[17]; const float* lnb = a.in[18]; const float* bsp = a.in[20];
    LAS float* stats = (LAS float*)(F.lds);
    LAS bf16* Vt = (LAS bf16*)(F.lds + 1024);
    int lane_ = F.lane, w_ = F.wave; asm volatile("" : "+v"(lane_)); asm volatile("" : "+s"(w_));
    const int lane = lane_, w = w_, fr = lane & 15, fq = lane >> 4; const int nks = (w < 4) ? 2 : 4;
    const float stv = (F.tid < 256) ? ((const float*)(F.ws + WS_SGST))[2 * (size_t)m0 + F.tid] : 0.f;
    v4u vpc[4];
#pragma unroll
    for (int j = 0; j < 4; ++j) { const int step = w + 8 * j, s = (step & 1) * 64 + lane, chunk = step >> 1; vpc[j] = *(const GAS v4u*)(proj + (size_t)(m0 + s) * DIN + NSH + 512 + hp * 128 + chunk * 8); }
    bf16x8 af[2][4];
#pragma unroll
    for (int hh = 0; hh < 2; ++hh)
#pragma unroll
        for (int ks = 0; ks < 4; ++ks) af[hh][ks] = (ks < nks) ? *(const GAS bf16x8*)(Wsp + (size_t)((hp * 2 + hh) * 128 + 16 * w + fr) * 128 + 32 * ks + 8 * fq) : (bf16x8){0, 0, 0, 0, 0, 0, 0, 0};
    unsigned short uu[2][4][4]; float bias[2][4];
#pragma unroll
    for (int hh = 0; hh < 2; ++hh)
#pragma unroll
        for (int reg = 0; reg < 4; ++reg) { const int t = 16 * w + 4 * fq + reg; bias[hh][reg] = bsp[(hp * 2 + hh) * 128 + t];
#pragma unroll
            for (int ni = 0; ni < 4; ++ni) uu[hh][reg][ni] = proj[(size_t)(m0 + t) * DIN + NSH + (hp * 2 + hh) * 64 + 16 * ni + fr]; }
    if (F.tid < 256) stats[F.tid] = stv;
    LBAR();
#pragma unroll
    for (int j = 0; j < 4; ++j) { const int step = w + 8 * j, s = (step & 1) * 64 + lane, chunk = step >> 1; const int ch0 = hp * 128 + chunk * 8;
        const float mean = stats[2 * s], rstd = stats[2 * s + 1]; float g[8]; gelu8(vpc[j], g);
#pragma unroll
        for (int jj = 0; jj < 8; ++jj) { const float v = (g[jj] - mean) * rstd * lng[ch0 + jj] + lnb[ch0 + jj]; Vt[(chunk * 8 + jj) * VT_STRIDE + s] = (bf16)f2bf(v); } }
    LBAR();
    f32x4 acc[2][4];
#pragma unroll
    for (int hh = 0; hh < 2; ++hh)
#pragma unroll
        for (int ni = 0; ni < 4; ++ni) acc[hh][ni] = (f32x4){0.f, 0.f, 0.f, 0.f};
#pragma unroll
    for (int hh = 0; hh < 2; ++hh)
#pragma unroll
        for (int ks = 0; ks < 4; ++ks) { if (ks < nks) {
#pragma unroll
            for (int ni = 0; ni < 4; ++ni) { const bf16x8 bfr = *(const LAS bf16x8*)(Vt + (hh * 64 + 16 * ni + fr) * VT_STRIDE + 32 * ks + 8 * fq);
                acc[hh][ni] = __builtin_amdgcn_mfma_f32_16x16x32_bf16(af[hh][ks], bfr, acc[hh][ni], 0, 0, 0); } } }
#pragma unroll
    for (int hh = 0; hh < 2; ++hh) { const int h = hp * 2 + hh;
#pragma unroll
        for (int reg = 0; reg < 4; ++reg) { const int t = 16 * w + 4 * fq + reg;
#pragma unroll
            for (int ni = 0; ni < 4; ++ni) { const int ch = h * 64 + 16 * ni + fr;
                Ycat[(size_t)(m0 + t) * D + 512 + ch] = (bf16)f2bf(fgelu(bf2f(uu[hh][reg][ni])) * (acc[hh][ni][reg] + bias[hh][reg])); } } }
    LBAR();
}

__device__ __forceinline__ void final_norm_rows(Frame& F, const Args& a) {
    const int gw = F.vcu * NWAVES + F.wave, NGW = F.G * NWAVES; const float* nf = a.in[31];
    for (int m = gw; m < M; m += NGW) {
        GAS f32x4* xr = (GAS f32x4*)(F.out + (size_t)m * D) + F.lane; f32x4 v[4]; float s = 0.f;
#pragma unroll
        for (int j = 0; j < 4; ++j) { v[j] = xr[64 * j]; s += (v[j].x * v[j].x + v[j].y * v[j].y) + (v[j].z * v[j].z + v[j].w * v[j].w); }
        const float rstd = __builtin_amdgcn_rsqf(wave_sum(s) * (1.f / D) + RMS_EPS);
#pragma unroll
        for (int j = 0; j < 4; ++j) { const f32x4 g = *(const f32x4*)(nf + 4 * F.lane + 256 * j); xr[64 * j] = v[j] * rstd * g; }
    }
}


__device__ __forceinline__ void convert_w13(Frame& F, const Args& a) {
    LAS float* scr = (LAS float*)(F.lds + RING_OFF + F.wave * 16384);
    const int gw = F.vcu * NWAVES + F.wave, NGW = F.G * NWAVES;
    bf16* WE13 = (bf16*)(F.ws + WS_WE13);
    for (int it = gw; it < NEXP * 256; it += NGW) {
        const int e = it >> 8, r = it & 255, which = r >> 7, q = r & 127, kb = q >> 3, nb = q & 7;
        transpose_item(a.in[25 + which] + (size_t)e * 262144, 1024, 256, WE13 + (size_t)e * 524288, 64 * kb, 32 * nb, swiglu_row(32 * nb, which), scr, F.lane);
    }
    __syncthreads();
}
constexpr int W2_ITEMS = NEXP * 128, W2_EARLY = 3328;
__device__ __forceinline__ void convert_w2_queue(Frame& F, const Args& a, int cw, unsigned first, unsigned last) {
    LAS float* scr = (LAS float*)(F.lds + RING_OFF + F.wave * 16384);
    bf16* WE2 = (bf16*)(F.ws + WS_WE2);
    for (;;) {
        unsigned base = 0; if (F.lane == 0) base = __hip_atomic_fetch_add((unsigned*)(F.ctl + cw), 4u, __ATOMIC_RELAXED, __HIP_MEMORY_SCOPE_AGENT);
        base = (unsigned)__builtin_amdgcn_readfirstlane((int)base) + first;
        if (base >= last) break;
#pragma unroll 1
        for (int i = 0; i < 4; ++i) { const int it = (int)base + i, e = it >> 7, q = it & 127, kb = q >> 5, nb = q & 31;
            transpose_item<true>(a.in[27] + (size_t)e * 262144, 256, 1024, WE2 + (size_t)e * 262144, 64 * kb, 32 * nb, 32 * nb, scr, F.lane); }
    }
    __syncthreads();
}

constexpr int DPP_X1 = 0xB1, DPP_X2 = 0x4E, DPP_X3 = 0x1B, DPP_HM = 0x141;
template <int CTRL> __device__ __forceinline__ int dpp_i(int x) { return __builtin_amdgcn_update_dpp(x, x, CTRL, 0xf, 0xf, false); }
template <int CTRL> __device__ __forceinline__ float dpp_f(float x) { return __builtin_bit_cast(float, dpp_i<CTRL>(__builtin_bit_cast(int, x))); }
__device__ __forceinline__ float oct_max_f(float v) { v = fmaxf(v, dpp_f<DPP_X1>(v)); v = fmaxf(v, dpp_f<DPP_X2>(v)); v = fmaxf(v, dpp_f<DPP_HM>(v)); return v; }
__device__ __forceinline__ int oct_max_i(int v) { v = max(v, dpp_i<DPP_X1>(v)); v = max(v, dpp_i<DPP_X2>(v)); v = max(v, dpp_i<DPP_HM>(v)); return v; }
__device__ __forceinline__ int oct_min_i(int v) { v = min(v, dpp_i<DPP_X1>(v)); v = min(v, dpp_i<DPP_X2>(v)); v = min(v, dpp_i<DPP_HM>(v)); return v; }
__device__ __forceinline__ void p11_route(Frame& F, const Args& a, int item0, int nitems) {
    const float* logits = (const float*)(F.ws + WS_LOGIT); const float* ebias = a.in[24];
    int* rowtok = (int*)(F.ws + WS_ROWTOK); int* slot = (int*)(F.ws + WS_SLOT); float* wt = (float*)(F.ws + WS_WT);
    unsigned* ecnt = (unsigned*)(F.ctl + CW_ECNT);
    LAS unsigned* lcnt = (LAS unsigned*)(F.lds);
    LAS unsigned* lbase = lcnt + 64;
    const int lane = F.lane, g = lane & 7, tl = lane >> 3; (void)nitems;
    if (F.tid < 64) lcnt[F.tid] = 0u;
    LDS_WAIT(); __syncthreads();
    int me[4]; float mw[4]; unsigned mr[4];
    float eb[8];
#pragma unroll
    for (int j = 0; j < 8; ++j) eb[j] = ebias[8 * g + j];
#pragma unroll
    for (int pass = 0; pass < 4; ++pass) {
        const int tok = item0 * 64 + pass * 64 + F.wave * 8 + tl;
        const f32x4 q0 = *(const GAS f32x4*)(logits + (size_t)tok * 64 + 8 * g), q1 = *(const GAS f32x4*)(logits + (size_t)tok * 64 + 8 * g + 4);
        float b[8]; b[0] = fsig(q0.x) + eb[0]; b[1] = fsig(q0.y) + eb[1]; b[2] = fsig(q0.z) + eb[2]; b[3] = fsig(q0.w) + eb[3]; b[4] = fsig(q1.x) + eb[4]; b[5] = fsig(q1.y) + eb[5]; b[6] = fsig(q1.z) + eb[6]; b[7] = fsig(q1.w) + eb[7];
        float m1 = -INFINITY, m2 = -INFINITY;
#pragma unroll
        for (int j = 0; j < 8; ++j) { const float v = b[j]; if (v > m1) { m2 = m1; m1 = v; } else if (v > m2) { m2 = v; } }
        const float gs = m1 + m2;
        int rank = 0;
#pragma unroll
        for (int x = 1; x < 8; ++x) {
            const float hm = dpp_f<DPP_HM>(gs); const float srcv = (x < 4) ? gs : hm; const int xx = x & 3;
            const float o = xx == 0 ? srcv : (xx == 1 ? dpp_f<DPP_X1>(srcv) : (xx == 2 ? dpp_f<DPP_X2>(srcv) : dpp_f<DPP_X3>(srcv)));
            const int og = (x < 4) ? (g ^ xx) : (7 - (g ^ xx)); rank += (o > gs || (o == gs && og < g)) ? 1 : 0; }
        const bool allowed = rank < 4;
#pragma unroll
        for (int j = 0; j < 8; ++j) if (!allowed) b[j] = -INFINITY;
        int my_e = 0; float my_s = 0.f, ssum = 0.f;
#pragma unroll
        for (int r = 0; r < 8; ++r) {
            float lv = b[0]; int li = 0;
#pragma unroll
            for (int j = 1; j < 8; ++j) if (b[j] > lv) { lv = b[j]; li = j; }
            const float best = oct_max_f(lv);
            const int cand = oct_min_i((lv == best) ? g : 8);
            const int bj = oct_max_i((g == cand) ? li : -1); const int be = 8 * cand + bj;
            float ebj = eb[0];
#pragma unroll
            for (int j = 1; j < 8; ++j) ebj = (li == j) ? eb[j] : ebj;
            const float bs = oct_max_f((g == cand) ? (lv - ebj) : -INFINITY);
            if (g == cand) {
#pragma unroll
                for (int j = 0; j < 8; ++j) if (li == j) b[j] = -INFINITY; }
            ssum += bs; if (g == r) { my_e = be; my_s = bs; }
        }
        me[pass] = my_e; mw[pass] = my_s * (2.5f / ssum);
        mr[pass] = __hip_atomic_fetch_add(lcnt + my_e, 1u, __ATOMIC_RELAXED, __HIP_MEMORY_SCOPE_WORKGROUP);
    }
    LDS_WAIT(); __syncthreads();
    if (F.tid < 64) { const unsigned n = lcnt[F.tid]; unsigned base = 0u; if (n) base = __hip_atomic_fetch_add(ecnt + F.tid, n, __ATOMIC_RELAXED, __HIP_MEMORY_SCOPE_AGENT); lbase[F.tid] = base; }
    LDS_WAIT(); __syncthreads();
#pragma unroll
    for (int pass = 0; pass < 4; ++pass) { const int tok = item0 * 64 + pass * 64 + F.wave * 8 + tl; const unsigned pos = lbase[me[pass]] + mr[pass];
        rowtok[(size_t)me[pass] * ECAP + pos] = tok; slot[(size_t)tok * 8 + g] = (me[pass] << 16) | (int)pos; wt[(size_t)tok * 8 + g] = mw[pass]; }
    LDS_WAIT(); __syncthreads();
}

__device__ __forceinline__ int build_tile_table(Frame& F) {
    LAS int* ttab = (LAS int*)(F.lds + LX_TTAB); LAS int* ecl = (LAS int*)(F.lds + LX_ECNT); LAS int* ecs = ecl + 64; LAS int* ntl = ecl + 128;
    const unsigned* ecnt = (const unsigned*)(F.ctl + CW_ECNT);
    if (F.wave == 0) { const int lane = F.lane;
        const int c = (int)__hip_atomic_load(ecnt + lane, __ATOMIC_RELAXED, __HIP_MEMORY_SCOPE_AGENT), nt = (c + 255) >> 8;
        const int cs = (int)dpp_scan_add((float)c) - c, ts = (int)dpp_scan_add((float)nt) - nt;
        ecl[lane] = c; ecs[lane] = cs;
        for (int j = 0; j < nt; ++j) ttab[ts + j] = (lane << 16) | j;
        if (lane == 63) ntl[0] = ts + nt; }
    LDS_WAIT(); __syncthreads();
    return __builtin_amdgcn_readfirstlane(ntl[0]);
}
__device__ __forceinline__ int tile_count(Frame& F) { return __builtin_amdgcn_readfirstlane(((const LAS int*)(F.lds + LX_ECNT))[128]); }
struct LoraOrder {
    static constexpr bool HAS_KO = true, TAILS = false; static constexpr int LD = 256;
    static __device__ __forceinline__ int koff(const pg8::Unit& u) { return (u.pn >= 4) ? 128 : 0; }
    pg8::StaticOrder S;
    __device__ __forceinline__ bool next(int i, pg8::Unit& u) const { return S.next(i, u); }
    __device__ __forceinline__ void a_ready(const pg8::Unit&) const {}
    __device__ __forceinline__ void done(const pg8::Unit&) const {}
};
struct MoeOrder {
    static constexpr bool HAS_KO = false, TAILS = true; static constexpr int LD = 0; static __device__ __forceinline__ int koff(const pg8::Unit&) { return 0; }
    const LAS int* ttab; const LAS int* ecl; const LAS int* ecs; int nunits, npn, pn_base, pn_per_e, up, G, c;
    __device__ __forceinline__ bool next(int i, pg8::Unit& u) const {
        const int L = i * G + c; if (L >= nunits) return false;
        const int q = L / npn, pl = L - q * npn;
        const int ent = __builtin_amdgcn_readfirstlane(ttab[q]); const int e = ent >> 16, j = ent & 0xffff;
        const int cn = __builtin_amdgcn_readfirstlane(ecl[e]), cs = __builtin_amdgcn_readfirstlane(ecs[e]);
        u.pm = q; u.pn = e * pn_per_e + pn_base + pl; const int v = cn - j * 256; u.a1 = v < 256 ? v : 256;
        u.a0 = up ? (e * ECAP + j * 256) : (cs + j * 256); u.a2 = pl; return true;
    }
    __device__ __forceinline__ void a_ready(const pg8::Unit&) const {}
    __device__ __forceinline__ void done(const pg8::Unit&) const {}
};

struct LightOrder {
    static constexpr bool HAS_KO = false, TAILS = false; static constexpr int LD = 0; static __device__ __forceinline__ int koff(const pg8::Unit&) { return 0; }
    int li, nl;
    __device__ __forceinline__ bool next(int i, pg8::Unit& u) const {
        if (li < 0) return false; const int L = i * nl + li; if (L >= 256) return false;
        u.pm = L >> 2; u.pn = L & 3; u.a0 = 0; u.a1 = 256; u.a2 = 0; return true; }
    __device__ __forceinline__ void a_ready(const pg8::Unit&) const {}
    __device__ __forceinline__ void done(const pg8::Unit&) const {}
};

__device__ __forceinline__ void combine_all(Frame& F, const Args& a) {
    const LAS int* ecs = (const LAS int*)(F.lds + LX_ECNT) + 64;
    const int* slot = (const int*)(F.ws + WS_SLOT); const float* wt = (const float*)(F.ws + WS_WT); const unsigned char* Y = (const unsigned char*)(F.ws + WS_Y);
    const float* modf = (const float*)(F.ws + WS_MODF); const float* nf = a.in[31];
    const int gw = F.vcu * NWAVES + F.wave, NGW = F.G * NWAVES; const int lane = F.lane, c0 = 16 * lane;
    for (int tok = gw; tok < M; tok += NGW) {
        const int b = tok >> 13;
        float acc[16], xs[16];
#pragma unroll
        for (int j = 0; j < 16; ++j) acc[j] = 0.f;
        { const bf16* sp = (const bf16*)(F.ws + WS_SH) + (size_t)tok * D + c0; const v4u q0 = *(const GAS v4u*)sp, q1 = *(const GAS v4u*)(sp + 8);
          xs[0] = bflo(q0.x); xs[1] = bfhi(q0.x); xs[2] = bflo(q0.y); xs[3] = bfhi(q0.y); xs[4] = bflo(q0.z); xs[5] = bfhi(q0.z); xs[6] = bflo(q0.w); xs[7] = bfhi(q0.w);
          xs[8] = bflo(q1.x); xs[9] = bfhi(q1.x); xs[10] = bflo(q1.y); xs[11] = bfhi(q1.y); xs[12] = bflo(q1.z); xs[13] = bfhi(q1.z); xs[14] = bflo(q1.w); xs[15] = bfhi(q1.w); }
        v4u yq[8]; float wk[8];
#pragma unroll
        for (int k = 0; k < 8; ++k) { const int sl = slot[(size_t)tok * 8 + k]; wk[k] = wt[(size_t)tok * 8 + k] * 0.125f;
            const int crow = ecs[sl >> 16] + (sl & 0xffff); yq[k] = *(const GAS v4u*)(Y + (size_t)crow * 1024 + c0); }
#pragma unroll
        for (int k = 0; k < 8; ++k) { const unsigned wd[4] = {yq[k].x, yq[k].y, yq[k].z, yq[k].w};
#pragma unroll
            for (int j = 0; j < 4; ++j) { acc[4 * j + 0] += wk[k] * __builtin_amdgcn_cvt_f32_fp8((int)wd[j], 0); acc[4 * j + 1] += wk[k] * __builtin_amdgcn_cvt_f32_fp8((int)wd[j], 1);
                acc[4 * j + 2] += wk[k] * __builtin_amdgcn_cvt_f32_fp8((int)wd[j], 2); acc[4 * j + 3] += wk[k] * __builtin_amdgcn_cvt_f32_fp8((int)wd[j], 3); } }
        float* xr = F.out + (size_t)tok * D + c0; const float* g2 = modf + b * 6144 + 5120 + c0; f32x4 xv[4]; float s = 0.f;
#pragma unroll
        for (int j = 0; j < 4; ++j) { const f32x4 x = (f32x4){xs[4 * j], xs[4 * j + 1], xs[4 * j + 2], xs[4 * j + 3]}, g = *(const GAS f32x4*)(g2 + 4 * j);
            xv[j] = x + g * (f32x4){acc[4 * j], acc[4 * j + 1], acc[4 * j + 2], acc[4 * j + 3]}; s += (xv[j].x * xv[j].x + xv[j].y * xv[j].y) + (xv[j].z * xv[j].z + xv[j].w * xv[j].w); }
        const float rstd = __builtin_amdgcn_rsqf(wave_sum(s) * (1.f / D) + RMS_EPS);
#pragma unroll
        for (int j = 0; j < 4; ++j) *(GAS f32x4*)(xr + 4 * j) = xv[j] * rstd * *(const GAS f32x4*)(nf + c0 + 4 * j);
    }
}


constexpr int RS = 72;
constexpr int NJOBS = 16 * 128;
typedef unsigned short us8 __attribute__((ext_vector_type(8)));
typedef _Float16 h8 __attribute__((ext_vector_type(8)));

__device__ __forceinline__ f32x4 mm16(const LAS bf16* pa, int sa, const LAS bf16* pb, int sb, f32x4 acc, int fr, int fq) {
#pragma unroll
    for (int ks = 0; ks < 2; ++ks) { const bf16x8 a = *(const LAS bf16x8*)(pa + fr * sa + 32 * ks + 8 * fq); const bf16x8 b = *(const LAS bf16x8*)(pb + fr * sb + 32 * ks + 8 * fq);
        acc = __builtin_amdgcn_mfma_f32_16x16x32_bf16(a, b, acc, 0, 0, 0); }
    return acc;
}
__device__ __forceinline__ f32x4 mm16g(const bf16* pa, int sa, const LAS bf16* pb, int sb, f32x4 acc, int fr, int fq) {
#pragma unroll
    for (int ks = 0; ks < 2; ++ks) { const bf16x8 a = *(const GAS bf16x8*)(pa + fr * sa + 32 * ks + 8 * fq); const bf16x8 b = *(const LAS bf16x8*)(pb + fr * sb + 32 * ks + 8 * fq);
        acc = __builtin_amdgcn_mfma_f32_16x16x32_bf16(a, b, acc, 0, 0, 0); }
    return acc;
}
__device__ __forceinline__ void unpack8(const v4u q, float (&o)[8]) { o[0] = bflo(q.x); o[1] = bfhi(q.x); o[2] = bflo(q.y); o[3] = bfhi(q.y); o[4] = bflo(q.z); o[5] = bfhi(q.z); o[6] = bflo(q.w); o[7] = bfhi(q.w); }
__device__ __forceinline__ v4u pack8(const float (&v)[8]) { v4u w; w.x = pk2(v[0], v[1]); w.y = pk2(v[2], v[3]); w.z = pk2(v[4], v[5]); w.w = pk2(v[6], v[7]); return w; }

__device__ __forceinline__ void p3_lin(Frame& F, const Args& a, int pm) {
    const bf16* proj = (const bf16*)(F.ws + WS_PROJ); bf16* Lin = (bf16*)(F.ws + WS_LIN); const float* mu = a.in[6];
    const int c0 = (F.tid & 31) * 8, r0 = F.tid >> 5;
    float muv[8];
#pragma unroll
    for (int j = 0; j < 8; ++j) muv[j] = mu[1536 + c0 + j];
#pragma unroll 1
    for (int half = 0; half < 4; ++half) { v4u pc[4], pq[4];
#pragma unroll
        for (int i = 0; i < 4; ++i) { const int m = pm * 256 + r0 + 16 * (4 * half + i); pc[i] = *(const GAS v4u*)(proj + (size_t)m * DIN + 1536 + c0);
            pq[i] = ((m & (SEQ - 1)) != 0) ? *(const GAS v4u*)(proj + (size_t)(m - 1) * DIN + 1536 + c0) : (v4u){0u, 0u, 0u, 0u}; }
#pragma unroll
        for (int i = 0; i < 4; ++i) { const int m = pm * 256 + r0 + 16 * (4 * half + i); float p[8], pp[8], o[8]; unpack8(pc[i], p); unpack8(pq[i], pp);
#pragma unroll
            for (int j = 0; j < 8; ++j) { const float sx = p[j] + (pp[j] - p[j]) * muv[j]; o[j] = c0 < 64 ? (2.f * fsig(2.f * sx) - 1.f) : (c0 < 128 ? sx : fsig(sx)); }
            *(GAS v4u*)(Lin + (size_t)m * 256 + c0) = pack8(o); } }
}


constexpr int L5_AT = 0, L5_BT = 9216, L5_KT = 18432, L5_RT = 27648, L5_BHT = 36864, L5_KHT = 46080, L5_VT = 55296, L5_AABF = 64512, L5_AAK = 80896, L5_RHS = 90112, L5_PS = 122880, L5_PB = 124928, L5_GL = 130048;
constexpr int L5_AHT = L5_BT, L5_UHT = L5_KT;
constexpr int L5_ARB = 111616, L5_ARK = 120832;
static_assert(L5_RHS + 9216 + 4096 + 8192 <= L5_ARB && L5_ARK + 9216 <= L5_GL && L5_GL + 256 <= RING_BYTES, "P5 LDS map");
constexpr int L5_AABB = L5_RHS, L5_WD = L5_RHS + 9216, L5_TMP = L5_RHS + 9216 + 4096;
__device__ __forceinline__ unsigned dpp_wave_shr1(unsigned x, unsigned first) { return (unsigned)__builtin_amdgcn_update_dpp((int)first, (int)x, 0x138, 0xf, 0xf, false); }
struct P5In { v4u pr, pk, pv, lr, qr, qk, qv, sg; h8 lw; };
__device__ __forceinline__ void p5_load(Frame& F, P5In& in, int jid) {
    const int chain = jid >> 7, c = jid & 127, b = chain >> 3, h = chain & 7, m = b * SEQ + c * 64 + F.lane, ch0 = 8 * F.wave;
    const bf16* pr = (const bf16*)(F.ws + WS_PROJ) + (size_t)m * DIN + h * 64 + ch0;
    in.pr = *(const GAS v4u*)(pr); in.pk = *(const GAS v4u*)(pr + 512); in.pv = *(const GAS v4u*)(pr + 1024);
    in.lw = *(const GAS h8*)((const _Float16*)(F.ws + WS_LW) + (size_t)m * 512 + h * 64 + ch0); in.lr = *(const GAS v4u*)((const bf16*)(F.ws + WS_AB) + (size_t)m * 512 + h * 64 + ch0);
    in.sg = *(const GAS v4u*)((const bf16*)(F.ws + WS_PROJ) + (size_t)(b * SEQ + c * 64 + 8 * h + F.wave) * DIN + NSH + 512 + 8 * F.lane);
    in.qr = (v4u){0u, 0u, 0u, 0u}; in.qk = in.qr; in.qv = in.qr;
    if (F.lane == 0 && c != 0) { in.qr = *(const GAS v4u*)(pr - DIN); in.qk = *(const GAS v4u*)(pr - DIN + 512); in.qv = *(const GAS v4u*)(pr - DIN + 1024); }
}
__device__ __forceinline__ v4u shfl_up1(const v4u x, const v4u first, int lane) {
    (void)lane; v4u r; r.x = dpp_wave_shr1(x.x, first.x); r.y = dpp_wave_shr1(x.y, first.y); r.z = dpp_wave_shr1(x.z, first.z); r.w = dpp_wave_shr1(x.w, first.w); return r;
}
__device__ __forceinline__ void p5_job(Frame& F, const Args& a, int jid, const P5In& in) {
    const int chain = jid >> 7, c = jid & 127, b = chain >> 3, h = chain & 7, m0 = b * SEQ + c * 64;
    bf16* RP = (bf16*)(F.ws + WS_AH) + (size_t)jid * 4096; bf16* OP = (bf16*)(F.ws + WS_UH) + (size_t)jid * 4096; bf16* PM = (bf16*)(F.ws + WS_PM) + (size_t)jid * 4096;
    float* QT = (float*)(F.ws + WS_QM) + (size_t)jid * 4096;
    bf16* VTg = (bf16*)F.out + (size_t)jid * 4096;
    float* bonus = (float*)(F.ws + WS_BONUS);
    const float* mu = a.in[6]; const float* k_k = a.in[12]; const float* k_a = a.in[13]; const float* r_k = a.in[14];
    LAS bf16* at = (LAS bf16*)(F.lds + L5_AT); LAS bf16* bt = (LAS bf16*)(F.lds + L5_BT); LAS bf16* kt = (LAS bf16*)(F.lds + L5_KT); LAS bf16* rt = (LAS bf16*)(F.lds + L5_RT);
    LAS bf16* bhT = (LAS bf16*)(F.lds + L5_BHT); LAS bf16* khT = (LAS bf16*)(F.lds + L5_KHT); LAS bf16* VT = (LAS bf16*)(F.lds + L5_VT);
    LAS float* Aabf = (LAS float*)(F.lds + L5_AABF); LAS bf16* Aak = (LAS bf16*)(F.lds + L5_AAK); LAS bf16* Arb = (LAS bf16*)(F.lds + L5_ARB); LAS bf16* Ark = (LAS bf16*)(F.lds + L5_ARK);
    LAS float* psum = (LAS float*)(F.lds + L5_PS); LAS float* pbon = (LAS float*)(F.lds + L5_PB); LAS float* GLs = (LAS float*)(F.lds + L5_GL);
    LAS bf16* AhT = (LAS bf16*)(F.lds + L5_AHT); LAS bf16* UhT = (LAS bf16*)(F.lds + L5_UHT);
    LAS bf16* AabB = (LAS bf16*)(F.lds + L5_AABB); LAS bf16* Wd = (LAS bf16*)(F.lds + L5_WD);
    int w_ = F.wave, lane_ = F.lane; asm volatile("" : "+s"(w_)); asm volatile("" : "+v"(lane_));
    const int w = w_, lane = lane_, t = lane, ch0 = 8 * w, fr = lane & 15, fq = lane >> 4;
    LAS bf16* tmpw = (LAS bf16*)(F.lds + L5_TMP) + w * 512;
    { float g[8]; gelu8(in.sg, g); float s = 0.f, ss = 0.f;
#pragma unroll
      for (int j = 0; j < 8; ++j) { s += g[j]; ss += g[j] * g[j]; }
      s = wave_sum(s); ss = wave_sum(ss);
      const float mean = s * (1.f / 512.f), var = fmaxf(ss * (1.f / 512.f) - mean * mean, 0.f);
      if (lane == 0) { v2u st; st.x = __builtin_bit_cast(unsigned, mean); st.y = __builtin_bit_cast(unsigned, __builtin_amdgcn_rsqf(var + 1e-5f)); *(GAS v2u*)((float*)(F.ws + WS_SGST) + 2 * (size_t)(m0 + 8 * h + w)) = st; } }
    float r[8], k[8], v[8], lw[8], lr[8], kkr[8], kmod[8], G[8], GL[8];
    {
        float pr_[8], pk_[8], pv_[8], qr_[8], qk_[8], qv_[8];
        unpack8(in.pr, pr_); unpack8(in.pk, pk_); unpack8(in.pv, pv_);
        unpack8(shfl_up1(in.pr, in.qr, lane), qr_); unpack8(shfl_up1(in.pk, in.qk, lane), qk_); unpack8(shfl_up1(in.pv, in.qv, lane), qv_);
        const h8 lwh = in.lw; unpack8(in.lr, lr);
        float ssq = 0.f, bon = 0.f;
#pragma unroll
        for (int j = 0; j < 8; ++j) { const int cc = h * 64 + ch0 + j;
            r[j] = pr_[j] + (qr_[j] - pr_[j]) * mu[cc]; k[j] = pk_[j] + (qk_[j] - pk_[j]) * mu[512 + cc]; v[j] = pv_[j] + (qv_[j] - pv_[j]) * mu[1024 + cc];
            lw[j] = (float)lwh[j]; kkr[j] = k[j] * k_k[cc]; ssq += kkr[j] * kkr[j]; kmod[j] = k[j] * (1.f + (lr[j] - 1.f) * k_a[cc]); bon += r[j] * kmod[j] * r_k[cc]; G[j] = lw[j]; }
        psum[w * 64 + t] = ssq; pbon[w * 64 + t] = bon;
#pragma unroll
        for (int j = 0; j < 8; ++j) { G[j] = dpp_scan_add(G[j]); GL[j] = __builtin_bit_cast(float, __builtin_amdgcn_readlane(__builtin_bit_cast(int, G[j]), 63)); }
        if (lane == 63) {
#pragma unroll
            for (int j = 0; j < 8; ++j) GLs[ch0 + j] = G[j]; }
    }
    LBAR();
    {
        float ssq = 0.f;
#pragma unroll
        for (int q = 0; q < 8; ++q) ssq += psum[q * 64 + t];
        const float invn = __builtin_amdgcn_rsqf(fmaxf(ssq, 1e-24f));
        if (w == 0) { float bon = 0.f;
#pragma unroll
            for (int q = 0; q < 8; ++q) bon += pbon[q * 64 + t];
            bonus[(size_t)jid * 64 + t] = bon; }
        float o_at[8], o_bt[8], o_kt[8], o_rt[8], o_bh[8], o_kh[8];
#pragma unroll
        for (int j = 0; j < 8; ++j) { const float kkn = kkr[j] * invn, bb = kkn * lr[j];
            const float eG = __expf(G[j]), enG = __builtin_amdgcn_rcpf(eG);
            const float eGm = __builtin_bit_cast(float, dpp_wave_shr1(__builtin_bit_cast(unsigned, eG), 0x3f800000u));
            const float eGL = __builtin_bit_cast(float, __builtin_amdgcn_readlane(__builtin_bit_cast(int, eG), 63)) * enG;
            o_at[j] = -kkn * eGm; o_bt[j] = bb * enG; o_kt[j] = kmod[j] * enG; o_rt[j] = r[j] * eG; o_bh[j] = bb * eGL; o_kh[j] = kmod[j] * eGL; }
        *(LAS v4u*)(at + t * RS + ch0) = pack8(o_at); *(LAS v4u*)(bt + t * RS + ch0) = pack8(o_bt); *(LAS v4u*)(kt + t * RS + ch0) = pack8(o_kt);
        *(LAS v4u*)(rt + t * RS + ch0) = pack8(o_rt);
#pragma unroll
        for (int j = 0; j < 8; ++j) { bhT[(ch0 + j) * RS + t] = (bf16)f2bf(o_bh[j]); khT[(ch0 + j) * RS + t] = (bf16)f2bf(o_kh[j]); const bf16 vb = (bf16)f2bf(v[j]); VT[(ch0 + j) * RS + t] = vb; VTg[(ch0 + j) * 64 + t] = vb; }
    }
    LBAR();
    {
        const int q = w >> 1; const LAS bf16* pa = (q < 2) ? at : rt; const LAS bf16* pb = (q & 1) ? kt : bt;
#pragma unroll
        for (int i2 = 0; i2 < 2; ++i2) { const int i = 2 * (w & 1) + i2, tt = 16 * i + fr;
#pragma unroll
            for (int ni = 0; ni < 4; ++ni) { f32x4 acc = (f32x4){0.f, 0.f, 0.f, 0.f};
                if (ni <= i) acc = mm16(pb + 16 * ni * RS, RS, pa + 16 * i * RS, RS, acc, fr, fq);
                const int s0 = 16 * ni + 4 * fq; float vv[4];
#pragma unroll
                for (int reg = 0; reg < 4; ++reg) { const int sx = s0 + reg; const bool keep = (q < 2) ? (sx < tt) : (sx <= tt); vv[reg] = keep ? acc[reg] : 0.f; }
                v2u pk; pk.x = pk2(vv[0], vv[1]); pk.y = pk2(vv[2], vv[3]);
                if (q == 0) {
#pragma unroll
                    for (int reg = 0; reg < 4; ++reg) Aabf[(s0 + reg) * 64 + tt] = vv[reg];
                    *(LAS v2u*)(AabB + tt * RS + s0) = pk; }
                else if (q == 1) *(LAS v2u*)(Aak + tt * RS + s0) = pk;
                else if (q == 2) *(LAS v2u*)(Arb + tt * RS + s0) = pk;
                else *(LAS v2u*)(Ark + tt * RS + s0) = pk; } }
    }
    LBAR();
    {
        { const int bi = lane >> 4, cc = lane & 15; float acc[16];
#pragma unroll
          for (int r = 0; r < 16; ++r) acc[r] = (r == cc) ? 1.f : 0.f;
#pragma unroll
          for (int sp = 0; sp < 15; ++sp) {
#pragma unroll
              for (int r4 = 0; r4 < 4; ++r4) { if (4 * r4 + 3 > sp) { const f32x4 av = *(const LAS f32x4*)(Aabf + (16 * bi + sp) * 64 + 16 * bi + 4 * r4);
                  if (4 * r4 + 0 > sp) acc[4 * r4 + 0] += av.x * acc[sp]; if (4 * r4 + 1 > sp) acc[4 * r4 + 1] += av.y * acc[sp]; if (4 * r4 + 2 > sp) acc[4 * r4 + 2] += av.z * acc[sp]; if (4 * r4 + 3 > sp) acc[4 * r4 + 3] += av.w * acc[sp]; } } }
#pragma unroll
          for (int r = 0; r < 16; ++r) { Wd[(bi * 16 + r) * 32 + cc] = (bf16)f2bf(acc[r]); Wd[(bi * 16 + r) * 32 + 16 + cc] = 0; } }
        LAS bf16* XT = (w < 4) ? (AhT + 16 * w * RS) : (UhT + 16 * (w - 4) * RS);
#pragma unroll
        for (int i = 0; i < 2; ++i) { const int e = lane + 64 * i; *(LAS v4u*)(XT + (e >> 3) * RS + (e & 7) * 8) = (v4u){0u, 0u, 0u, 0u}; }
        *(LAS v4u*)(tmpw + fr * 32 + 16 + 8 * (fq & 1)) = (v4u){0u, 0u, 0u, 0u};
        LDS_WAIT();
#pragma unroll
        for (int i = 0; i < 4; ++i) {
            f32x4 acc;
            if (w < 4) {
#pragma unroll
                for (int reg = 0; reg < 4; ++reg) acc[reg] = bf2f(at[(16 * i + 4 * fq + reg) * RS + 16 * w + fr]);
            } else acc = mm16(Aak + 16 * i * RS, RS, VT + 16 * (w - 4) * RS, RS, (f32x4){0.f, 0.f, 0.f, 0.f}, fr, fq);
            if (i > 0) acc = mm16(AabB + 16 * i * RS, RS, XT, RS, acc, fr, fq);
            { v2u pk; pk.x = pk2(acc[0], acc[1]); pk.y = pk2(acc[2], acc[3]); *(LAS v2u*)(tmpw + fr * 32 + 4 * fq) = pk; }
            LDS_WAIT();
            const bf16x8 wa = *(const LAS bf16x8*)(Wd + (i * 16 + fr) * 32 + 8 * fq); const bf16x8 tb = *(const LAS bf16x8*)(tmpw + fr * 32 + 8 * fq);
            const f32x4 x = __builtin_amdgcn_mfma_f32_16x16x32_bf16(wa, tb, (f32x4){0.f, 0.f, 0.f, 0.f}, 0, 0, 0);
            v2u xp; xp.x = pk2(x[0], x[1]); xp.y = pk2(x[2], x[3]);
            *(LAS v2u*)(XT + fr * RS + 16 * i + 4 * fq) = xp;
            LDS_WAIT();
        }
    }
    LBAR();
    if (w < 4) {
#pragma unroll
        for (int ni = 0; ni < 4; ++ni) { f32x4 acc = mm16(AhT + 16 * ni * RS, RS, bhT + 16 * w * RS, RS, (f32x4){0.f, 0.f, 0.f, 0.f}, fr, fq);
            if (ni == w) { const float eg = __expf(GLs[16 * w + fr]);
#pragma unroll
                for (int reg = 0; reg < 4; ++reg) if (4 * fq + reg == fr) acc[reg] += eg; }
            v2u pk; pk.x = pk2(acc[0], acc[1]); pk.y = pk2(acc[2], acc[3]);
            *(GAS v2u*)(PM + ((((w * 2 + (ni >> 1)) * 4 + 2 * (ni & 1) + (fq >> 1)) * 16 + fr) << 3) + 4 * (fq & 1)) = pk; }
#pragma unroll
        for (int ni = 0; ni < 4; ++ni) { const v2u r4 = *(const LAS v2u*)(rt + (16 * w + fr) * RS + 16 * ni + 4 * fq);
            f32x4 acc = mm16(AhT + 16 * ni * RS, RS, Arb + 16 * w * RS, RS, (f32x4){bflo(r4.x), bfhi(r4.x), bflo(r4.y), bfhi(r4.y)}, fr, fq);
            v2u pk; pk.x = pk2(acc[0], acc[1]); pk.y = pk2(acc[2], acc[3]); *(GAS v2u*)(RP + (16 * w + fr) * 64 + 16 * ni + 4 * fq) = pk; }
    } else { const int i = w - 4;
#pragma unroll
        for (int ni = 0; ni < 4; ++ni) { f32x4 acc = mm16(bhT + 16 * i * RS, RS, UhT + 16 * ni * RS, RS, (f32x4){0.f, 0.f, 0.f, 0.f}, fr, fq);
            acc = mm16(khT + 16 * i * RS, RS, VT + 16 * ni * RS, RS, acc, fr, fq);
            { v2u qp; qp.x = pk2(acc[0], acc[1]); qp.y = pk2(acc[2], acc[3]); *(GAS v2u*)((bf16*)QT + (((ni * 4 + i) * 4 + fq) * 16 + fr) * 4) = qp; } }
#pragma unroll
        for (int ni = 0; ni < 4; ++ni) { f32x4 acc = mm16(Arb + 16 * i * RS, RS, UhT + 16 * ni * RS, RS, (f32x4){0.f, 0.f, 0.f, 0.f}, fr, fq);
            acc = mm16(Ark + 16 * i * RS, RS, VT + 16 * ni * RS, RS, acc, fr, fq);
            v2u pk; pk.x = pk2(acc[0], acc[1]); pk.y = pk2(acc[2], acc[3]); *(GAS v2u*)(OP + (16 * ni + fr) * 64 + 16 * i + 4 * fq) = pk; } }
    LBAR();
}

constexpr int P6_HT = 0, P6_HTE = 16 * RS, P6_RING = 16;
__device__ __forceinline__ void p6_scan(Frame& F, int chain, int vt) {
    const int w = F.wave, lane = F.lane, fr = lane & 15, fq = lane >> 4;
    if (w >= 4) {
        __builtin_amdgcn_s_barrier();
#pragma unroll 1
        for (int c = 0; c < 128; ++c) __builtin_amdgcn_s_barrier();
        return;
    }
    const int mi = w;
    const char* psrc = (const char*)((const bf16*)(F.ws + WS_PM) + (size_t)chain * 128 * 4096) + mi * 2048 + lane * 16;
    const char* qsrc = (const char*)((const bf16*)(F.ws + WS_QM) + (size_t)chain * 128 * 8192 + vt * 1024) + mi * 512 + lane * 8;
    bf16x8 rp[P6_RING][2]; v2u rq[P6_RING];
#define P6_LD(j_, c_) do { const int _c = (c_) < 128 ? (c_) : 127; rp[j_][0] = *(const GAS bf16x8*)(psrc + (size_t)_c * 8192); rp[j_][1] = *(const GAS bf16x8*)(psrc + (size_t)_c * 8192 + 1024); \
        rq[j_] = *(const GAS v2u*)(qsrc + (size_t)_c * 16384); } while (0)
#pragma unroll
    for (int j = 0; j < P6_RING; ++j) P6_LD(j, j);
    LAS bf16* HT = (LAS bf16*)(F.lds + P6_HT);
    bf16* H0c = (bf16*)(F.ws + WS_H0) + (size_t)chain * 128 * 4096;
    const int hoff = fr * RS + 16 * mi + 4 * fq;
    const int goff = (16 * vt + fr) * 64 + 16 * mi + 4 * fq;
    { const v2u z = (v2u){0u, 0u}; *(LAS v2u*)(HT + hoff) = z; *(GAS v2u*)(H0c + goff) = z; }
    asm volatile("s_waitcnt lgkmcnt(0)" ::: "memory");
    __builtin_amdgcn_s_barrier();
#pragma unroll 1
    for (int c0 = 0; c0 < 128; c0 += P6_RING) {
#pragma unroll
        for (int j = 0; j < P6_RING; ++j) { const int c = c0 + j;
            const LAS bf16* HTr = HT + (j & 1) * P6_HTE; LAS bf16* HTw = HT + ((j + 1) & 1) * P6_HTE;
            bf16x8 hb[2];
#pragma unroll
            for (int ks = 0; ks < 2; ++ks) hb[ks] = *(const LAS bf16x8*)(HTr + fr * RS + 32 * ks + 8 * fq);
            f32x4 acc = (f32x4){bflo(rq[j].x), bfhi(rq[j].x), bflo(rq[j].y), bfhi(rq[j].y)};
#pragma unroll
            for (int ks = 0; ks < 2; ++ks) acc = __builtin_amdgcn_mfma_f32_16x16x32_bf16(rp[j][ks], hb[ks], acc, 0, 0, 0);
            P6_LD(j, c + P6_RING);
            v2u pk; pk.x = pk2(acc[0], acc[1]); pk.y = pk2(acc[2], acc[3]);
            *(LAS v2u*)(HTw + hoff) = pk;
            if (c + 1 < 128) *(GAS v2u*)(H0c + (size_t)(c + 1) * 4096 + goff) = pk;
            asm volatile("s_waitcnt lgkmcnt(0)" ::: "memory");
            __builtin_amdgcn_s_barrier();
        }
    }
#undef P6_LD
}

__device__ __forceinline__ void p7_pair(Frame& F, const Args& a, int pair) {
    int w_ = F.wave, lane_ = F.lane; asm volatile("" : "+s"(w_)); asm volatile("" : "+v"(lane_));
    const int w = w_, lane = lane_, fr = lane & 15, fq = lane >> 4, w4 = w & 3, js = w >> 2, jid = 2 * pair + js;
    const int chain = jid >> 7, c = jid & 127, b = chain >> 3, h = chain & 7, m0 = b * SEQ + c * 64;
    const bf16* RP = (const bf16*)(F.ws + WS_AH) + (size_t)jid * 4096; const bf16* OP = (const bf16*)(F.ws + WS_UH) + (size_t)jid * 4096; const bf16* H0 = (const bf16*)(F.ws + WS_H0) + (size_t)jid * 4096;
    const bf16* VTg = (const bf16*)F.out + (size_t)jid * 4096;
    const float* bonus = (const float*)(F.ws + WS_BONUS); const bf16* Gb = (const bf16*)(F.ws + WS_GB); bf16* Ycat = (bf16*)(F.ws + WS_YCAT);
    const float* lng = a.in[15]; const float* lnb = a.in[16];
    LAS bf16* H0T = (LAS bf16*)(F.lds + js * 9216);
    const int tl = w4 * 64 + lane; v4u sh0[2];
#pragma unroll
    for (int i = 0; i < 2; ++i) { const int e = tl + 256 * i, row = e >> 3, c8 = (e & 7) * 8; sh0[i] = *(const GAS v4u*)(H0 + row * 64 + c8); }
    v2u op[4], vv[4];
#pragma unroll
    for (int ni = 0; ni < 4; ++ni) { op[ni] = *(const GAS v2u*)(OP + (16 * ni + fr) * 64 + 16 * w4 + 4 * fq); vv[ni] = *(const GAS v2u*)(VTg + (16 * ni + fr) * 64 + 16 * w4 + 4 * fq); }
    bf16x8 fa[2];
#pragma unroll
    for (int ks = 0; ks < 2; ++ks) fa[ks] = *(const GAS bf16x8*)(RP + (16 * w4 + fr) * 64 + 32 * ks + 8 * fq);
    unsigned short gq[4][4]; float bon4[4];
#pragma unroll
    for (int reg = 0; reg < 4; ++reg) { const int tt = 16 * w4 + 4 * fq + reg; bon4[reg] = bonus[(size_t)jid * 64 + tt];
#pragma unroll
        for (int ni = 0; ni < 4; ++ni) gq[reg][ni] = Gb[(size_t)(m0 + tt) * 512 + h * 64 + 16 * ni + fr]; }
#pragma unroll
    for (int i = 0; i < 2; ++i) { const int e = tl + 256 * i, row = e >> 3, c8 = (e & 7) * 8; *(LAS v4u*)(H0T + row * RS + c8) = sh0[i]; }
    LBAR();
    f32x4 o[4];
#pragma unroll
    for (int ni = 0; ni < 4; ++ni) { f32x4 acc = (f32x4){bflo(op[ni].x), bfhi(op[ni].x), bflo(op[ni].y), bfhi(op[ni].y)};
#pragma unroll
        for (int ks = 0; ks < 2; ++ks) acc = __builtin_amdgcn_mfma_f32_16x16x32_bf16(fa[ks], *(const LAS bf16x8*)(H0T + (16 * ni + fr) * RS + 32 * ks + 8 * fq), acc, 0, 0, 0);
        o[ni] = acc; }
#pragma unroll
    for (int reg = 0; reg < 4; ++reg) { const int tt = 16 * w4 + 4 * fq + reg, m = m0 + tt;
        float s = (o[0][reg] + o[1][reg]) + (o[2][reg] + o[3][reg]);
        s = row16_sum(s);
        const float mean = s * (1.f / 64.f); float q = 0.f;
#pragma unroll
        for (int ni = 0; ni < 4; ++ni) { const float d = o[ni][reg] - mean; q += d * d; }
        q = row16_sum(q);
        const float rstd = __builtin_amdgcn_rsqf(q * (1.f / 64.f) + 64e-5f); const float bon = bon4[reg];
#pragma unroll
        for (int ni = 0; ni < 4; ++ni) { const int vch = 16 * ni + fr, cc = h * 64 + vch;
            const unsigned vw = (reg & 2) ? vv[ni].y : vv[ni].x; const float vtv = (reg & 1) ? bfhi(vw) : bflo(vw);
            const float y = (o[ni][reg] - mean) * rstd * lng[cc] + lnb[cc] + bon * vtv;
            Ycat[(size_t)m * D + cc] = (bf16)f2bf(y * bf2f(gq[reg][ni])); } }
    LBAR();
}


__global__ void __launch_bounds__(NWAVES * 64, 2) mega_fwd(Args args) {
    extern __shared__ __attribute__((aligned(16))) unsigned char lds[];
    Frame F;
    F.lds = (LAS unsigned char*)lds;
    F.MISC = (volatile LAS unsigned*)(F.lds + MISC_OFF);
    F.tid = threadIdx.x; F.lane = F.tid & 63; F.wave = __builtin_amdgcn_readfirstlane(F.tid >> 6);
    F.G = gridDim.x; { const int bx = blockIdx.x; F.vcu = (F.G % 8 == 0) ? (bx % 8) * (F.G / 8) + bx / 8 : bx; }
    F.ws = args.ws; F.out = args.out;
    F.ctl = (gu32*)(F.ws + WS_CTL);
    for (int u = F.tid; u < (LDS_BYTES - LDSCTL_OFF) / 4; u += NWAVES * 64) ((LAS unsigned*)(F.lds + LDSCTL_OFF))[u] = 0u;
    __syncthreads();
    XcdBarrier bar = xcd_barrier_post((unsigned*)(F.ctl + CW_BAR) + args.li * XCD_BAR_WORDS, F.MISC + 8);
    const int lo = args.ph_lo, hi = args.ph_hi;
#define IN(k) (lo <= (k) && (k) < hi)
#define SEAM(k) do { if (IN(k) && IN((k) + 1)) xcd_barrier(bar); } while (0)
    const int gw = F.vcu * NWAVES + F.wave, NGW = F.G * NWAVES; (void)gw; (void)NGW;

    if (IN(0)) { p0_prologue(F, args); } SEAM(0);
    if (IN(1)) { p1_h(F, args); } SEAM(1);
    if (IN(2)) {
        pg8::Gemm g{(const pg8::bf16_t*)(F.ws + WS_HBUF), (const pg8::bf16_t*)(F.ws + WS_WIN), M, DIN, D}; pg8::StaticOrder S; S.init(M, DIN, F.G, (int)blockIdx.x);
        pg8::EpiBf16Plain E{(pg8::bf16_t*)(F.ws + WS_PROJ), DIN};
        pg8::gemm_phase<pg8::EpiBf16Plain, pg8::StaticOrder, true, true>(F.lds + RING_OFF, g, S, E);
        if ((int)blockIdx.x >= 192) p0_late(F, args, (int)blockIdx.x - 192, 64);
    } SEAM(2);
    if (IN(4)) {
        { const int c = (int)blockIdx.x; int pm0 = 8 * (c & 7) + ((c >> 3) & 7);
          if (pm0 >= 0) { p3_lin(F, args, __builtin_amdgcn_readfirstlane(pm0)); VM_WAIT(); __syncthreads(); } }
        int krun = 128; asm volatile("" : "+s"(krun));
        pg8::Gemm g{(const pg8::bf16_t*)(F.ws + WS_LIN), (const pg8::bf16_t*)(F.ws + WS_WLORA), M, 1536, krun}; LoraOrder S; S.S.init(M, 1536, F.G, (int)blockIdx.x);
        pg8::EpiLora E{(_Float16*)(F.ws + WS_LW), (pg8::bf16_t*)(F.ws + WS_AB), (pg8::bf16_t*)(F.ws + WS_GB), args.in[7], args.in[9]};
        pg8::gemm_phase<pg8::EpiLora, LoraOrder, true, true>(F.lds + RING_OFF, g, S, E);
    } SEAM(4);
    if (IN(5)) { { P5In cur, nxt; int j = (int)blockIdx.x; if (j < NJOBS) p5_load(F, cur, j);
          for (; j < NJOBS; j += F.G) { if (j + F.G < NJOBS) p5_load(F, nxt, j + F.G); p5_job(F, args, j, cur); cur = nxt; } } } SEAM(5);
    if (IN(6)) { if ((int)blockIdx.x < 64) { p6_scan(F, (int)blockIdx.x & 15, (int)blockIdx.x >> 4); __syncthreads();
        }
        for (;;) {
            if (F.tid == 0) F.MISC[16] = __hip_atomic_fetch_add((unsigned*)(F.ctl + CW_SGUQ), 1u, __ATOMIC_RELAXED, __HIP_MEMORY_SCOPE_AGENT);
            LDS_WAIT(); __syncthreads(); const int it = (int)F.MISC[16]; __syncthreads();
            if (it >= 512) break;
            sgu_item(F, args, it); } } SEAM(6);
    if (IN(7)) { for (int pr = (int)blockIdx.x; pr < NJOBS / 2; pr += F.G) p7_pair(F, args, pr); } SEAM(7);
    if (IN(8)) {
        pg8::Gemm g{(const pg8::bf16_t*)(F.ws + WS_YCAT), (const pg8::bf16_t*)(F.ws + WS_WOUT), M, D, D}; pg8::StaticOrder S; S.init(M, D, F.G, (int)blockIdx.x);
        pg8::EpiResGate E{args.in[0], (pg8::bf16_t*)F.out, (const float*)(F.ws + WS_MODF) + 2048, 6144};
        pg8::gemm_phase<pg8::EpiResGate, pg8::StaticOrder, true, true>(F.lds + RING_OFF, g, S, E);
        convert_w13(F, args);
    } SEAM(8);
    if (IN(9)) { p9_h2(F, args); } SEAM(9);
    if (IN(10)) {
        { pg8::Gemm g{(const pg8::bf16_t*)(F.ws + WS_H2), (const pg8::bf16_t*)(F.ws + WS_WS13), M, 768, D}; pg8::StaticOrder S; S.init(M, 768, F.G, (int)blockIdx.x);
          pg8::EpiSwiglu<true> E{(pg8::bf16_t*)(F.ws + WS_ACTS), (float*)(F.ws + WS_LOGIT), 3};
          pg8::gemm_phase<pg8::EpiSwiglu<true>, pg8::StaticOrder, true, true>(F.lds + RING_OFF, g, S, E); }
        { const int c = (int)blockIdx.x;
          if (F.G == 256 && (c >> 6) == 2) { VM_WAIT(); __syncthreads(); __builtin_amdgcn_fence(__ATOMIC_ACQUIRE, "agent"); VM_WAIT(); p11_route(F, args, (8 * (c & 7) + ((c >> 3) & 7)) * 4, 4); } }
        if ((int)blockIdx.x >= 192) convert_w2_queue(F, args, CW_CVQ, 0u, (unsigned)W2_EARLY);
    } SEAM(10);
    if (IN(12)) {
        const int ntl = build_tile_table(F);
        { pg8::Gemm g{(const pg8::bf16_t*)(F.ws + WS_H2), (const pg8::bf16_t*)(F.ws + WS_WE13), M, 512, D};
          MoeOrder S{(const LAS int*)(F.lds + LX_TTAB), (const LAS int*)(F.lds + LX_ECNT), (const LAS int*)(F.lds + LX_ECNT) + 64, ntl * 2, 2, 0, 2, 1, F.G, F.vcu};
          pg8::EpiSwiglu<false> E{(pg8::bf16_t*)(F.ws + WS_ACT), nullptr, 2};
          pg8::gemm_phase_gather<pg8::EpiSwiglu<false>, MoeOrder, true>(F.lds + RING_OFF, g, S, E, (const int*)(F.ws + WS_ROWTOK), (LAS int*)(F.lds + LX_GTAB)); }
        { pg8::Gemm g{(const pg8::bf16_t*)(F.ws + WS_ACTS), (const pg8::bf16_t*)(F.ws + WS_WS2), M, D, 256};
          const int nun = ntl * 2, rounds = (nun + F.G - 1) / F.G, heavy = nun - (rounds - 1) * F.G;
          LightOrder S{heavy >= F.G ? F.vcu : (F.vcu >= heavy ? F.vcu - heavy : -1), heavy >= F.G ? F.G : F.G - heavy};
          pg8::EpiResAddBf16 E{(const pg8::bf16_t*)F.out, (pg8::bf16_t*)(F.ws + WS_SH), (const float*)(F.ws + WS_MODF) + 5120, 6144};
          pg8::gemm_phase<pg8::EpiResAddBf16, LightOrder, true, true>(F.lds + RING_OFF, g, S, E); }
        convert_w2_queue(F, args, CW_CVQ2, (unsigned)W2_EARLY, (unsigned)W2_ITEMS);
    } SEAM(12);
    if (IN(13)) {
        const int ntl = tile_count(F);
        pg8::Gemm g{(const pg8::bf16_t*)(F.ws + WS_ACT), (const pg8::bf16_t*)(F.ws + WS_WE2), ACT_ROWS, D, 256};
        MoeOrder S{(const LAS int*)(F.lds + LX_TTAB), (const LAS int*)(F.lds + LX_ECNT), (const LAS int*)(F.lds + LX_ECNT) + 64, ntl * 4, 4, 0, 4, 0, F.G, F.vcu};
        pg8::EpiDownY E{(unsigned char*)(F.ws + WS_Y)};
        pg8::gemm_phase<pg8::EpiDownY, MoeOrder, true, true>(F.lds + RING_OFF, g, S, E);
    } SEAM(13);
    if (IN(14)) { combine_all(F, args); }
#undef IN
#undef SEAM
}

extern "C" void kernel_launch(void* const* d_in, const int* in_sizes, int n_in, void* d_out, int out_size, void* d_ws, size_t ws_size, hipStream_t stream) {
    static int grid = 0;
    if (grid == 0) {
        if (n_in != 32 || in_sizes[0] != M * D || out_size != M * D || ws_size < WS_END) { fprintf(stderr, "kernel_launch: unexpected shapes (n_in %d, ws %zu); nothing launched\n", n_in, ws_size); grid = -1; return; }
        int dev = 0, cus = 0, per_cu = 0;
        if (hipGetDevice(&dev) != hipSuccess || hipDeviceGetAttribute(&cus, hipDeviceAttributeMultiprocessorCount, dev) != hipSuccess) { grid = -1; return; }
        if (hipFuncSetAttribute((const void*)mega_fwd, hipFuncAttributeMaxDynamicSharedMemorySize, LDS_BYTES) != hipSuccess) { fprintf(stderr, "kernel_launch: hipFuncSetAttribute failed\n"); grid = -1; return; }
        if (hipOccupancyMaxActiveBlocksPerMultiprocessor(&per_cu, (const void*)mega_fwd, NWAVES * 64, LDS_BYTES) != hipSuccess || per_cu < 1) { fprintf(stderr, "kernel_launch: occupancy query says %d blocks per CU\n", per_cu); }
        (void)hipGetLastError();
        grid = cus;
        if (cus != 256) { fprintf(stderr, "kernel_launch: built for a 256-CU device (the static unit ownership in the lora and router phases assumes 256 workgroups); found %d CUs, nothing launched\n", cus); grid = -1; return; }
    }
    if (grid < 0) return;
    (void)hipMemsetAsync((char*)d_ws + WS_CTL, 0, CTL_ZERO_BYTES, stream);
    Args a{};
    for (int i = 0; i < 32; ++i) a.in[i] = (const float*)d_in[i];
    a.out = (float*)d_out; a.ws = (unsigned char*)d_ws;
    a.ph_lo = 0; a.ph_hi = 15; a.li = 0;
    hipLaunchKernelGGL(mega_fwd, dim3(grid), dim3(NWAVES * 64), LDS_BYTES, stream, a);
}
```
